# Optimizing an MI355X kernel written in HIP

```python
import jax, jax.numpy as jnp
from jax import lax
import numpy as np

D_MODEL = 1024
BATCH = 32
SEQ = 256
DEPTH = 4
DEC_BATCH = 2
DEC_SEQ = 1024
PAST_LEN = 256

GRID_W = 64
HEAD_DIM = 64
A_HEADS = 8
A_KV_HEADS = 2
B_HEADS = 8
B_KV_HEADS = 2
WINDOW = 128
Q_BLOCK = 128
ROPE_BASE = 10000.0
A_WIDTH = A_HEADS * HEAD_DIM
B_WIDTH = B_HEADS * HEAD_DIM
KV_A = A_KV_HEADS * HEAD_DIM
KV_B = B_KV_HEADS * HEAD_DIM
EVEN_IN = 2 * A_WIDTH + 2 * KV_A + 2 * B_WIDTH + 2 * KV_B
EVEN_MIX = A_WIDTH + B_WIDTH
C_WIDTH = D_MODEL
C_GROUPS = 4
C_GROUP_DIM = C_WIDTH // C_GROUPS
ODD_IN = 2 * C_WIDTH
N_EVEN = (DEPTH + 1) // 2
N_ODD = DEPTH // 2
EPS = 1e-6
NEG_BIG = -1e30

kernel_name = "hybrid_dit_prefix_attn_fourier_step"


def rms_norm(x, g):
    xf = x.astype(jnp.float32)
    y = xf * lax.rsqrt(jnp.mean(xf * xf, axis=-1, keepdims=True) + EPS)
    return (y * g.astype(jnp.float32)).astype(x.dtype)


def ada_mod(cvec, w, b):
    m = jax.nn.silu(cvec) @ w + b
    return jnp.split(m, 3, axis=-1)


def modulate(h, shift, scale):
    return h * (1 + scale) + shift


def grid_rope_tables(n_tok):
    rows = n_tok // GRID_W
    row = jnp.repeat(jnp.arange(rows), GRID_W).astype(jnp.float32)
    col = jnp.tile(jnp.arange(GRID_W), rows).astype(jnp.float32)
    half = HEAD_DIM // 2
    inv = 1.0 / (ROPE_BASE ** (jnp.arange(0, half, 2, dtype=jnp.float32) / half))
    ang = jnp.concatenate([row[:, None] * inv, col[:, None] * inv], axis=-1)
    return jnp.cos(ang), jnp.sin(ang)


def apply_rope(x, cos, sin):
    b, s, h, d = x.shape
    xr = x.astype(jnp.float32).reshape(b, s, h, 2, 2, d // 4)
    x1, x2 = xr[..., 0, :], xr[..., 1, :]
    c = cos.reshape(1, s, 1, 2, d // 4)
    sn = sin.reshape(1, s, 1, 2, d // 4)
    y = jnp.stack([x1 * c - x2 * sn, x2 * c + x1 * sn], axis=-2)
    return y.reshape(b, s, h, d).astype(x.dtype)


def softmax_sink(sc, sink):
    sink = sink.astype(jnp.float32)
    m = jnp.maximum(jnp.max(sc, axis=-1, keepdims=True), sink)
    p = jnp.exp(sc - m)
    return p / (jnp.sum(p, axis=-1, keepdims=True) + jnp.exp(sink - m))


def dense_block_attention(q, k, v, sink=None):
    b, s, h, d = q.shape
    kvh = k.shape[2]
    g = h // kvh
    nb = s // Q_BLOCK
    qb = (q * (d ** -0.5)).reshape(b, nb, Q_BLOCK, kvh, g, d).transpose(1, 0, 2, 3, 4, 5)

    def one_block(qblk):
        sc = jnp.einsum("bqkgd,btkd->bkgqt", qblk, k).astype(jnp.float32)
        if sink is None:
            p = jax.nn.softmax(sc, axis=-1)
        else:
            p = softmax_sink(sc, sink.reshape(1, kvh, g, 1, 1))
        return jnp.einsum("bkgqt,btkd->bqkgd", p.astype(v.dtype), v)

    o = lax.map(one_block, qb)
    return o.transpose(1, 0, 2, 3, 4, 5).reshape(b, s, h * d)


def window_attention_with_ctx(q, k, v, k_ctx, v_ctx, sink):
    b, s, h, d = q.shape
    kvh = k.shape[2]
    g = h // kvh
    nb = s // Q_BLOCK
    nband = 2 * (WINDOW // Q_BLOCK) + 1
    L = nband * Q_BLOCK
    pad = ((0, 0), (WINDOW, WINDOW), (0, 0), (0, 0))
    kp = jnp.pad(k, pad).reshape(b, nb + nband - 1, Q_BLOCK, kvh, d)
    vp = jnp.pad(v, pad).reshape(b, nb + nband - 1, Q_BLOCK, kvh, d)
    kband = jnp.concatenate([kp[:, j:j + nb] for j in range(nband)], axis=2)
    vband = jnp.concatenate([vp[:, j:j + nb] for j in range(nband)], axis=2)
    qi = jnp.arange(Q_BLOCK)[:, None]
    kj = jnp.arange(L)[None, :]
    rel = kj - WINDOW - qi
    kpos = jnp.arange(nb)[:, None, None] * Q_BLOCK + kj[None] - WINDOW
    mask = (jnp.abs(rel)[None] <= WINDOW) & (kpos >= 0) & (kpos < s)
    qb = (q * (d ** -0.5)).reshape(b, nb, Q_BLOCK, kvh, g, d)
    s_loc = jnp.einsum("bnqkgd,bnlkd->bnkgql", qb, kband).astype(jnp.float32)
    s_loc = jnp.where(mask[None, :, None, None], s_loc, NEG_BIG)
    s_ctx = jnp.einsum("bnqkgd,btkd->bnkgqt", qb, k_ctx).astype(jnp.float32)
    p = softmax_sink(jnp.concatenate([s_loc, s_ctx], axis=-1), sink.reshape(1, 1, kvh, g, 1, 1))
    p = p.astype(v.dtype)
    o = (jnp.einsum("bnkgql,bnlkd->bnqkgd", p[..., :L], vband)
         + jnp.einsum("bnkgqt,btkd->bnqkgd", p[..., L:], v_ctx))
    return o.reshape(b, s, h * d)


def split_even(p):
    sizes = [A_WIDTH, KV_A, KV_A, A_WIDTH, B_WIDTH, KV_B, KV_B, B_WIDTH]
    idx = [int(i) for i in np.cumsum(sizes)[:-1]]
    return jnp.split(p, idx, axis=-1)


def even_projections(h, w_in, gq, gk):
    b, s, _ = h.shape
    qa, ka, va, ga, qb, kb, vb, gb = split_even(h @ w_in)
    qa = rms_norm(qa.reshape(b, s, A_HEADS, HEAD_DIM), gq)
    ka = rms_norm(ka.reshape(b, s, A_KV_HEADS, HEAD_DIM), gk)
    va = va.reshape(b, s, A_KV_HEADS, HEAD_DIM)
    qb = qb.reshape(b, s, B_HEADS, HEAD_DIM)
    kb = kb.reshape(b, s, B_KV_HEADS, HEAD_DIM)
    vb = vb.reshape(b, s, B_KV_HEADS, HEAD_DIM)
    return qa, ka, va, ga, qb, kb, vb, gb


def even_ctx(h, w_in, w_out, gq, gk, sink):
    qa, ka, va, ga, qb, kb, vb, gb = even_projections(h, w_in, gq, gk)
    oa = dense_block_attention(qa, ka, va)
    ob = dense_block_attention(qb, kb, vb, sink)
    y = jnp.concatenate([oa * jax.nn.silu(ga), ob * jax.nn.silu(gb)], axis=-1) @ w_out
    return y, ka, va, kb, vb


def even_lat(h, w_in, w_out, gq, gk, sink, ka_ctx, va_ctx, kb_ctx, vb_ctx, cos, sin):
    qa, ka, va, ga, qb, kb, vb, gb = even_projections(h, w_in, gq, gk)
    qa, ka = apply_rope(qa, cos, sin), apply_rope(ka, cos, sin)
    qb, kb = apply_rope(qb, cos, sin), apply_rope(kb, cos, sin)
    oa = dense_block_attention(qa, jnp.concatenate([ka, ka_ctx], axis=1),
                               jnp.concatenate([va, va_ctx], axis=1))
    ob = window_attention_with_ctx(qb, kb, vb, kb_ctx, vb_ctx, sink)
    return jnp.concatenate([oa * jax.nn.silu(ga), ob * jax.nn.silu(gb)], axis=-1) @ w_out


def fourier_mix(u):
    b, s, _ = u.shape
    ug = u.astype(jnp.float32).reshape(b, s, C_GROUPS, C_GROUP_DIM)
    f = jnp.fft.fft2(ug, axes=(1, 3), norm="ortho")
    return jnp.real(f).reshape(b, s, C_WIDTH).astype(u.dtype)


def odd_mix(h, w_in, w_out):
    u, gate = jnp.split(h @ w_in, 2, axis=-1)
    return (fourier_mix(u) * jax.nn.silu(gate)) @ w_out


def setup_inputs(seed: int = 0) -> dict:
    key = jax.random.key(seed)
    ks = jax.random.split(key, 20)

    def nrm(k, shape, s):
        return jax.random.normal(k, shape, jnp.float32) * s

    cache_shape = (DEC_BATCH, N_EVEN, PAST_LEN, A_KV_HEADS, HEAD_DIM)
    return {
        "x_prompt": nrm(ks[0], (BATCH, SEQ, D_MODEL), 1.0),
        "x_sample": nrm(ks[1], (DEC_BATCH, DEC_SEQ, D_MODEL), 1.0),
        "cache_k_a": nrm(ks[2], cache_shape, 1.0),
        "cache_v_a": nrm(ks[3], cache_shape, 1.0),
        "cache_k_b": nrm(ks[4], (DEC_BATCH, N_EVEN, PAST_LEN, B_KV_HEADS, HEAD_DIM), 1.0),
        "cache_v_b": nrm(ks[5], (DEC_BATCH, N_EVEN, PAST_LEN, B_KV_HEADS, HEAD_DIM), 1.0),
        "c": nrm(ks[6], (DEC_BATCH, D_MODEL), 1.0),
        "c_ctx": nrm(ks[7], (D_MODEL,), 1.0),
        "norm_g": 1.0 + nrm(ks[8], (DEPTH, D_MODEL), 0.02),
        "ada_w": nrm(ks[9], (DEPTH, D_MODEL, 3 * D_MODEL), 0.5 * D_MODEL ** -0.5),
        "ada_b": nrm(ks[10], (DEPTH, 3 * D_MODEL), 0.02),
        "even_w_in": nrm(ks[11], (N_EVEN, D_MODEL, EVEN_IN), D_MODEL ** -0.5),
        "even_w_out": nrm(ks[12], (N_EVEN, EVEN_MIX, D_MODEL), EVEN_MIX ** -0.5),
        "qk_g_q": 1.0 + nrm(ks[13], (N_EVEN, HEAD_DIM), 0.02),
        "qk_g_k": 1.0 + nrm(ks[14], (N_EVEN, HEAD_DIM), 0.02),
        "sink_logit": nrm(ks[15], (N_EVEN, B_HEADS), 0.5),
        "odd_w_in": nrm(ks[16], (N_ODD, D_MODEL, ODD_IN), D_MODEL ** -0.5),
        "odd_w_out": nrm(ks[17], (N_ODD, C_WIDTH, D_MODEL), C_WIDTH ** -0.5),
        "final_g": 1.0 + nrm(ks[18], (D_MODEL,), 0.02),
    }


def reference(x_prompt, x_sample, cache_k_a, cache_v_a, cache_k_b, cache_v_b, c, c_ctx,
              norm_g, ada_w, ada_b, even_w_in, even_w_out, qk_g_q, qk_g_k, sink_logit,
              odd_w_in, odd_w_out, final_g):
    cos, sin = grid_rope_tables(x_sample.shape[1])
    xc = x_prompt
    xl = x_sample
    ka_list, va_list, kb_list, vb_list = [], [], [], []
    for l in range(DEPTH):
        i = l // 2
        shc, scc, gtc = ada_mod(c_ctx, ada_w[l], ada_b[l])
        shl, scl, gtl = ada_mod(c, ada_w[l], ada_b[l])
        hc = modulate(rms_norm(xc, norm_g[l]), shc, scc)
        hl = modulate(rms_norm(xl, norm_g[l]), shl[:, None], scl[:, None])
        if l % 2 == 0:
            yc, ka, va, kb, vb = even_ctx(hc, even_w_in[i], even_w_out[i],
                                          qk_g_q[i], qk_g_k[i], sink_logit[i])
            ka_list.append(ka)
            va_list.append(va)
            kb_list.append(kb)
            vb_list.append(vb)
            yl = even_lat(hl, even_w_in[i], even_w_out[i], qk_g_q[i], qk_g_k[i], sink_logit[i],
                          cache_k_a[:, i], cache_v_a[:, i], cache_k_b[:, i], cache_v_b[:, i],
                          cos, sin)
        else:
            yc = odd_mix(hc, odd_w_in[i], odd_w_out[i])
            yl = odd_mix(hl, odd_w_in[i], odd_w_out[i])
        xc = xc + gtc * yc
        xl = xl + gtl[:, None] * yl
    y_prompt = rms_norm(xc, final_g)
    y_sample = rms_norm(xl, final_g)
    new_k_a = jnp.stack(ka_list, axis=1)
    new_v_a = jnp.stack(va_list, axis=1)
    new_k_b = jnp.stack(kb_list, axis=1)
    new_v_b = jnp.stack(vb_list, axis=1)
    return (y_prompt, y_sample, new_k_a, new_v_a, new_k_b, new_v_b)
```

```cpp
#include <hip/hip_runtime.h>
#include <hip/hip_cooperative_groups.h>
#include <stdint.h>
#include <cstdio>

#ifndef MEGA
#define MEGA 1
#endif

typedef unsigned short bf16_t;
using bf16x8 = __attribute__((ext_vector_type(8))) __bf16;
using f32x16 = __attribute__((ext_vector_type(16))) float;
typedef __bf16 bf16x2_t __attribute__((ext_vector_type(2)));
using u32x4 = __attribute__((ext_vector_type(4))) unsigned;
using u32x2 = __attribute__((ext_vector_type(2))) unsigned;

#define NTOK 10240
#define NCTX 8192
#define DM 1024
#define SMEM_BYTES 73728
#define LDK 1088
#define LDU 10304
#define LDD1 2112
#define LDD2 576
#define LDC 320
#define WF_ROWS 2048

struct Params {
    const float *x_prompt, *x_sample, *cache_k_a, *cache_v_a, *cache_k_b, *cache_v_b, *c, *c_ctx, *norm_g, *ada_w, *ada_b,
        *even_w_in, *even_w_out, *qk_g_q, *qk_g_k, *sink, *odd_w_in, *odd_w_out, *final_g;
    float* out;
    unsigned* bar;
    int* ctr;
    float* part;
    float* shiftW;
    float* mod;
    float2* rope;
    bf16_t *h, *R, *mix, *winT_e, *woutT_e, *woutT_o, *wfT, *wu, *D1024, *D256, *Cc, *Sc, *vT_ctx, *vT_lat, *cK, *cVT;
};

__device__ __forceinline__ unsigned pack2(float a, float b) {
    bf16x2_t v = {(__bf16)a, (__bf16)b};
    return *(unsigned*)&v;
}
__device__ __forceinline__ bf16_t f2bf(float a) {
    __bf16 v = (__bf16)a;
    return *(bf16_t*)&v;
}
__device__ __forceinline__ float bf_lo(unsigned u) { return __uint_as_float(u << 16); }
__device__ __forceinline__ float bf_hi(unsigned u) { return __uint_as_float(u & 0xffff0000u); }
using f32x4n = __attribute__((ext_vector_type(4))) float;
__device__ __forceinline__ float4 ld_nt4(const float* p) { const f32x4n v = __builtin_nontemporal_load((const f32x4n*)p); return make_float4(v[0], v[1], v[2], v[3]); }
__device__ __forceinline__ float silu_f(float x) { return x / (1.0f + __expf(-x)); }
__device__ __forceinline__ int tid_l() { int t = threadIdx.x; asm volatile("" : "+v"(t)); return t; }

#define CTR_STRIDE 64
#define CTR_SLOT_WORDS 512
__device__ __forceinline__ unsigned xcc_id_hw() { return (unsigned)__builtin_amdgcn_s_getreg((3 << 11) | 20) & 0xFu; }
__device__ __forceinline__ int tq_next(int* ctr, int per_q, int myx, int& q, volatile int* s_slot, int tid, int per_q_odd = -1) {
    if (tid == 0) {
        int res = -1;
        while (q < 8) {
            const int qq = (myx + q) & 7;
            const int lim = (per_q_odd >= 0 && (qq & 1)) ? per_q_odd : per_q;
            const int idx = atomicAdd(&ctr[qq * CTR_STRIDE], 1);
            if (idx < lim) { res = (qq << 16) | idx; break; }
            q++;
        }
        *s_slot = res;
    }
    __syncthreads();
    const int r = __builtin_amdgcn_readfirstlane(*s_slot);
    __syncthreads();
    return r;
}

#define XB_TMO      128
#define XB_XCNT(j)  (256  + 64 * (j))
#define XB_XSUB(j)  (1280 + 64 * (j))
#define XB_XGEN(j)  (2304 + 64 * (j))
#define XB_TOP      3328
#define XB_TOPGEN   3392
#define XCD_BAR_WORDS 3456
#define XB_SPIN_CAP (1u << 20)
#define LAS __attribute__((address_space(3)))

__device__ __forceinline__ unsigned xb_ld(unsigned* p) { return __hip_atomic_load(p, __ATOMIC_RELAXED, __HIP_MEMORY_SCOPE_AGENT); }
__device__ __forceinline__ unsigned xb_add(unsigned* p, unsigned v) { return __hip_atomic_fetch_add(p, v, __ATOMIC_RELAXED, __HIP_MEMORY_SCOPE_AGENT); }
__device__ __forceinline__ unsigned xb_xcc_id() { return (unsigned)__builtin_amdgcn_s_getreg((3 << 11) | 20) & 0xFu; }
#define XB_SPIN(cond, bar) do { unsigned _sp = 0; while (cond) { __builtin_amdgcn_s_sleep(1); \
    if ((++_sp & 255u) == 0u) { if (xb_ld(&(bar)[XB_TMO])) break; if (_sp > XB_SPIN_CAP) { atomicAdd(&(bar)[XB_TMO], 1u); break; } } } } while (0)

struct XcdBarrier { unsigned* bar; unsigned x; volatile LAS unsigned* st; };

__device__ __forceinline__ XcdBarrier xcd_barrier_post(unsigned* bar, volatile LAS unsigned* st) {
    XcdBarrier b; b.bar = bar; b.x = xb_xcc_id(); b.st = st;
    if (threadIdx.x == 0) (void)xb_add(&bar[XB_XCNT(b.x)], 1u);
    return b;
}
__device__ __forceinline__ void xcd_barrier_complete(unsigned* bar, unsigned x, unsigned& nloc, unsigned& nx) {
    const unsigned G = gridDim.x * gridDim.y * gridDim.z;
    unsigned sum, cnt, mine, sp = 0u;
    for (;;) {
        sum = 0u; cnt = 0u; mine = 0u;
#pragma unroll
        for (unsigned j = 0; j < 16; ++j) { const unsigned c = xb_ld(&bar[XB_XCNT(j)]); sum += c; cnt += (c > 0u) ? 1u : 0u; mine = (j == x) ? c : mine; }
        if (sum == G) break;
        __builtin_amdgcn_s_sleep(1);
        if ((++sp & 255u) == 0u) { if (xb_ld(&bar[XB_TMO])) break; if (sp > XB_SPIN_CAP) { atomicAdd(&bar[XB_TMO], 1u); break; } }
    }
    nloc = mine > 0u ? mine : 1u; nx = cnt > 0u ? cnt : 1u;
}
__device__ __forceinline__ void xcd_barrier(const XcdBarrier& b) {
    asm volatile("s_waitcnt vmcnt(0)" ::: "memory");
    __syncthreads();
    if (threadIdx.x == 0) {
        unsigned* bar = b.bar;
        __builtin_amdgcn_s_waitcnt(0);
        unsigned nloc = b.st[0], nx = b.st[1];
        if (nloc == 0u) { xcd_barrier_complete(bar, b.x, nloc, nx); b.st[0] = nloc; b.st[1] = nx; }
        const unsigned old = xb_add(&bar[XB_XSUB(b.x)], 1u);
        const unsigned gen = old / nloc;
        if (old + 1u == (gen + 1u) * nloc) {
            __builtin_amdgcn_fence(__ATOMIC_RELEASE, "agent");
            asm volatile("s_waitcnt vmcnt(0)" ::: "memory");
            const unsigned og = xb_add(&bar[XB_TOP], 1u);
            const unsigned tg = og / nx;
            if (og + 1u == (tg + 1u) * nx) xb_add(&bar[XB_TOPGEN], 1u);
            else XB_SPIN(xb_ld(&bar[XB_TOPGEN]) == tg, bar);
            __builtin_amdgcn_fence(__ATOMIC_ACQUIRE, "agent");
            xb_add(&bar[XB_XGEN(b.x)], 1u);
            asm volatile("s_waitcnt vmcnt(0)" ::: "memory");
        } else {
            XB_SPIN(xb_ld(&bar[XB_XGEN(b.x)]) == gen, bar);
            __builtin_amdgcn_fence(__ATOMIC_ACQUIRE, "agent");
            asm volatile("s_waitcnt vmcnt(0)" ::: "memory");
        }
    }
    __syncthreads();
}

#define CS_LD 132
__device__ __forceinline__ void gemm_core(const bf16_t* __restrict__ A, int lda, const bf16_t* __restrict__ B0, const bf16_t* __restrict__ B1,
                                          int ksplit, int ldb, int K, char* smem) {
    bf16_t* As = (bf16_t*)smem;
    bf16_t* Bs = As + 2 * 128 * 72;
    const int tid = tid_l(), lane = tid & 63, w = tid >> 6;
    const int wm = w >> 1, wn = w & 1, r = lane & 31, hh = lane >> 5;
    const int lrow = tid >> 3, lkc = tid & 7;
    const unsigned voffA = (unsigned)(lrow * lda + lkc * 8) * 2u, voffB = (unsigned)(lrow * ldb + lkc * 8) * 2u;
    const __amdgpu_buffer_rsrc_t rsA = __builtin_amdgcn_make_buffer_rsrc((void*)A, 0, 0x7fffffff, 0x00020000);
    u32x4 ra[4], rb[4], rc[4], rd[4];
    f32x16 acc[2][2];
#pragma unroll
    for (int a = 0; a < 2; a++)
#pragma unroll
        for (int b = 0; b < 2; b++)
#pragma unroll
            for (int e = 0; e < 16; e++) acc[a][b][e] = 0.f;

    const int nk = K >> 6;
#define GEMM_LOAD(RA_, RB_, T_) { \
        const int t_ = ((T_) < nk) ? (T_) : (nk - 1); \
        const int k0_ = t_ << 6; \
        const bf16_t* Bp_ = (k0_ < ksplit) ? (B0 + k0_) : (B1 + (k0_ - ksplit)); \
        const __amdgpu_buffer_rsrc_t rsB_ = __builtin_amdgcn_make_buffer_rsrc((void*)Bp_, 0, 0x7fffffff, 0x00020000); \
        _Pragma("unroll") \
        for (int i = 0; i < 4; i++) { \
            RA_[i] = __builtin_amdgcn_raw_buffer_load_b128(rsA, voffA, ((32 * i) * lda + k0_) * 2, 0); \
            RB_[i] = __builtin_amdgcn_raw_buffer_load_b128(rsB_, voffB, ((32 * i) * ldb) * 2, 0); \
        } }
#define GEMM_WRITE(RA_, RB_, BUF_) { \
        _Pragma("unroll") \
        for (int i = 0; i < 4; i++) { \
            *(u32x4*)(As + (BUF_) * 128 * 72 + (lrow + 32 * i) * 72 + lkc * 8) = RA_[i]; \
            *(u32x4*)(Bs + (BUF_) * 128 * 72 + (lrow + 32 * i) * 72 + lkc * 8) = RB_[i]; \
        } }
    GEMM_LOAD(ra, rb, 0);
    GEMM_WRITE(ra, rb, 0);
    GEMM_LOAD(rc, rd, 1);
    GEMM_LOAD(ra, rb, 2);
    __syncthreads();
#define GEMM_COMPUTE(BUF) { \
        const bf16_t* as_ = As + (BUF) * 128 * 72 + (wm * 64 + r) * 72 + hh * 8; \
        const bf16_t* bs_ = Bs + (BUF) * 128 * 72 + (wn * 64 + r) * 72 + hh * 8; \
        _Pragma("unroll") \
        for (int ks = 0; ks < 4; ks++) { \
            bf16x8 a0 = *(const bf16x8*)(as_ + ks * 16); \
            bf16x8 a1 = *(const bf16x8*)(as_ + 32 * 72 + ks * 16); \
            bf16x8 b0 = *(const bf16x8*)(bs_ + ks * 16); \
            bf16x8 b1 = *(const bf16x8*)(bs_ + 32 * 72 + ks * 16); \
            acc[0][0] = __builtin_amdgcn_mfma_f32_32x32x16_bf16(a0, b0, acc[0][0], 0, 0, 0); \
            acc[0][1] = __builtin_amdgcn_mfma_f32_32x32x16_bf16(a0, b1, acc[0][1], 0, 0, 0); \
            acc[1][0] = __builtin_amdgcn_mfma_f32_32x32x16_bf16(a1, b0, acc[1][0], 0, 0, 0); \
            acc[1][1] = __builtin_amdgcn_mfma_f32_32x32x16_bf16(a1, b1, acc[1][1], 0, 0, 0); \
        } }
#define GEMM_COMPUTE_LD(BUF_, RA_, RB_, T_, WB_, PK_, LD_) { \
        const int t_ = ((T_) < nk) ? (T_) : (nk - 1); \
        const int k0_ = t_ << 6; \
        const bf16_t* Bp_ = (k0_ < ksplit) ? (B0 + k0_) : (B1 + (k0_ - ksplit)); \
        const __amdgpu_buffer_rsrc_t rsB_ = __builtin_amdgcn_make_buffer_rsrc((void*)Bp_, 0, 0x7fffffff, 0x00020000); \
        const bf16_t* as_ = As + (BUF_) * 128 * 72 + (wm * 64 + r) * 72 + hh * 8; \
        const bf16_t* bs_ = Bs + (BUF_) * 128 * 72 + (wn * 64 + r) * 72 + hh * 8; \
        bf16x8 a0 = *(const bf16x8*)(as_), a1 = *(const bf16x8*)(as_ + 32 * 72), b0 = *(const bf16x8*)(bs_), b1 = *(const bf16x8*)(bs_ + 32 * 72); \
        bf16x8 a0n = a0, a1n = a1, b0n = b0, b1n = b1; \
        _Pragma("unroll") \
        for (int ks = 0; ks < 4; ks++) { \
            if (ks < 3) {   \
                a0n = *(const bf16x8*)(as_ + (ks + 1) * 16); a1n = *(const bf16x8*)(as_ + 32 * 72 + (ks + 1) * 16); \
                b0n = *(const bf16x8*)(bs_ + (ks + 1) * 16); b1n = *(const bf16x8*)(bs_ + 32 * 72 + (ks + 1) * 16); \
            } \
            if (PK_) *(u32x4*)(As + (WB_) * 128 * 72 + (lrow + 32 * ks) * 72 + lkc * 8) = RA_[ks];        \
            if (LD_) RA_[ks] = __builtin_amdgcn_raw_buffer_load_b128(rsA, voffA, ((32 * ks) * lda + k0_) * 2, 0);                      \
            acc[0][0] = __builtin_amdgcn_mfma_f32_32x32x16_bf16(a0, b0, acc[0][0], 0, 0, 0); \
            acc[0][1] = __builtin_amdgcn_mfma_f32_32x32x16_bf16(a0, b1, acc[0][1], 0, 0, 0); \
            __builtin_amdgcn_sched_barrier(0); \
            if (PK_) *(u32x4*)(Bs + (WB_) * 128 * 72 + (lrow + 32 * ks) * 72 + lkc * 8) = RB_[ks]; \
            if (LD_) RB_[ks] = __builtin_amdgcn_raw_buffer_load_b128(rsB_, voffB, ((32 * ks) * ldb) * 2, 0); \
            acc[1][0] = __builtin_amdgcn_mfma_f32_32x32x16_bf16(a1, b0, acc[1][0], 0, 0, 0); \
            acc[1][1] = __builtin_amdgcn_mfma_f32_32x32x16_bf16(a1, b1, acc[1][1], 0, 0, 0); \
            __builtin_amdgcn_sched_barrier(0); \
            a0 = a0n; a1 = a1n; b0 = b0n; b1 = b1n; \
        } }
    for (int kt = 0; kt + 2 < nk; kt += 2) {
        GEMM_COMPUTE_LD(0, rc, rd, kt + 3, 1, true, true);
        __syncthreads();
        GEMM_COMPUTE_LD(1, ra, rb, kt + 4, 0, true, true);
        __syncthreads();
    }
    GEMM_COMPUTE_LD(0, rc, rd, nk - 1, 1, true, false);
    __syncthreads();
    GEMM_COMPUTE_LD(1, ra, rb, nk - 1, 0, false, false);
    __syncthreads();
    float* Cs = (float*)smem;
#pragma unroll
    for (int mi = 0; mi < 2; mi++)
#pragma unroll
        for (int ni = 0; ni < 2; ni++)
#pragma unroll
            for (int e = 0; e < 16; e++) {
                const int row = wm * 64 + mi * 32 + (e & 3) + 8 * (e >> 2) + 4 * hh;
                const int col = wn * 64 + ni * 32 + r;
                Cs[row * CS_LD + col] = acc[mi][ni][e];
            }
    __syncthreads();
}

__device__ __forceinline__ void cs_read_row(const float* Cs, int row, int half, float (&v)[64]) {
#pragma unroll
    for (int j = 0; j < 16; j++) {
        float4 f = *(const float4*)(Cs + row * CS_LD + half * 64 + j * 4);
        v[4 * j] = f.x; v[4 * j + 1] = f.y; v[4 * j + 2] = f.z; v[4 * j + 3] = f.w;
    }
}
__device__ __forceinline__ void store_row_bf16(bf16_t* dst, const float (&v)[64]) {
#pragma unroll
    for (int j = 0; j < 8; j++) {
        uint4 u;
        u.x = pack2(v[8 * j], v[8 * j + 1]); u.y = pack2(v[8 * j + 2], v[8 * j + 3]);
        u.z = pack2(v[8 * j + 4], v[8 * j + 5]); u.w = pack2(v[8 * j + 6], v[8 * j + 7]);
        *(uint4*)(dst + 8 * j) = u;
    }
}
__device__ __forceinline__ void store_row_f32(float* dst, const float (&v)[64]) {
#pragma unroll
    for (int j = 0; j < 16; j++) *(float4*)(dst + 4 * j) = make_float4(v[4 * j], v[4 * j + 1], v[4 * j + 2], v[4 * j + 3]);
}
__device__ __forceinline__ void cs_store_col(const float* Cs, int col, int rgrp, bf16_t* dst_col, const float* aff = nullptr) {
    const float sw = aff ? aff[128 + col] : 0.f;
#pragma unroll
    for (int ch = 0; ch < 8; ch++) {
        const int r0 = rgrp * 64 + ch * 8;
        float f[8];
#pragma unroll
        for (int e = 0; e < 8; e++) { f[e] = Cs[(r0 + e) * CS_LD + col]; if (aff) f[e] = f[e] * aff[r0 + e] + sw; }
        uint4 u;
        u.x = pack2(f[0], f[1]); u.y = pack2(f[2], f[3]); u.z = pack2(f[4], f[5]); u.w = pack2(f[6], f[7]);
        *(uint4*)(dst_col + r0) = u;
    }
}

#define AFF_OFF 67584
__device__ __forceinline__ float aff_prefetch(const Params& p, int l, int m0, int ncol0, int tid) {
    if (tid < 128) {
        const int t = m0 + tid;
        float ss = 0.f;
#pragma unroll
        for (int j = 0; j < 8; j++) ss += p.part[(size_t)j * NTOK + t];
        return rsqrtf(ss * (1.0f / 1024.0f) + 1e-6f);
    }
    const int mv = (m0 < NCTX) ? 0 : 1 + ((m0 - NCTX) >> 10);
    return p.shiftW[(size_t)(l * 3 + mv) * 3072 + ncol0 + (tid - 128)];
}
__device__ __forceinline__ void aff_publish(char* smem, float pre, int tid) {
    ((float*)(smem + AFF_OFF))[tid] = pre;
    __syncthreads();
}
__device__ __forceinline__ void aff_apply_row(const char* smem, int row, int half, float (&v)[64]) {
    const float* a = (const float*)(smem + AFF_OFF);
    const float rs = a[row];
#pragma unroll
    for (int j = 0; j < 16; j++) {
        const float4 s = *(const float4*)(a + 128 + half * 64 + 4 * j);
        v[4 * j] = v[4 * j] * rs + s.x; v[4 * j + 1] = v[4 * j + 1] * rs + s.y; v[4 * j + 2] = v[4 * j + 2] * rs + s.z; v[4 * j + 3] = v[4 * j + 3] * rs + s.w;
    }
}
__device__ void compute_shiftW(const Params& p) {
    const int tidn = tid_l(), lane = tidn & 63;
    const int gw = blockIdx.x * 4 + (tidn >> 6), nw = gridDim.x * 4;
    for (int task = gw; task < WF_ROWS + 2560 + WF_ROWS; task += nw) {
        int L, n; const bf16_t* Wr;
        if (task < WF_ROWS) { L = 1; n = task; Wr = p.wfT + (size_t)n * LDK; }
        else if (task < WF_ROWS + 2560) { L = 2; n = task - WF_ROWS; Wr = p.winT_e + (size_t)2560 * LDK + (size_t)n * LDK; }
        else { L = 3; n = task - WF_ROWS - 2560; Wr = p.wfT + (size_t)WF_ROWS * LDK + (size_t)n * LDK; }
        const u32x4 w0 = *(const u32x4*)(Wr + lane * 16), w1 = *(const u32x4*)(Wr + lane * 16 + 8);
        float wf[16];
        wf[0] = bf_lo(w0[0]); wf[1] = bf_hi(w0[0]); wf[2] = bf_lo(w0[1]); wf[3] = bf_hi(w0[1]);
        wf[4] = bf_lo(w0[2]); wf[5] = bf_hi(w0[2]); wf[6] = bf_lo(w0[3]); wf[7] = bf_hi(w0[3]);
        wf[8] = bf_lo(w1[0]); wf[9] = bf_hi(w1[0]); wf[10] = bf_lo(w1[1]); wf[11] = bf_hi(w1[1]);
        wf[12] = bf_lo(w1[2]); wf[13] = bf_hi(w1[2]); wf[14] = bf_lo(w1[3]); wf[15] = bf_hi(w1[3]);
        float acc[3];
#pragma unroll
        for (int mv = 0; mv < 3; mv++) {
            const float* sh = p.mod + (size_t)(L * 3 + mv) * 3072 + lane * 16;
            float a = 0.f;
#pragma unroll
            for (int j = 0; j < 4; j++) {
                const float4 s = *(const float4*)(sh + 4 * j);
                a += s.x * wf[4 * j] + s.y * wf[4 * j + 1] + s.z * wf[4 * j + 2] + s.w * wf[4 * j + 3];
            }
            acc[mv] = a;
        }
#pragma unroll
        for (int o = 32; o >= 1; o >>= 1) { acc[0] += __shfl_xor(acc[0], o); acc[1] += __shfl_xor(acc[1], o); acc[2] += __shfl_xor(acc[2], o); }
        if (lane == 0) {
            p.shiftW[(size_t)(L * 3 + 0) * 3072 + n] = acc[0];
            p.shiftW[(size_t)(L * 3 + 1) * 3072 + n] = acc[1];
            p.shiftW[(size_t)(L * 3 + 2) * 3072 + n] = acc[2];
        }
    }
}

__device__ void ada_item(const Params& p, int item, char* smem) {
    const int tid = tid_l();
    const int l = item / 96, cgp = item % 96, col0 = cgp * 32;
    float* sc = (float*)smem;
    float* red = sc + 3072;
    for (int i = tid; i < 3072; i += 256) {
        const int v = i >> 10, k = i & 1023;
        const float cv = (v == 0) ? p.c_ctx[k] : p.c[(v - 1) * 1024 + k];
        sc[i] = silu_f(cv);
    }
    __syncthreads();
    const int cl = tid & 7, slice = tid >> 3;
    float acc[12];
#pragma unroll
    for (int e = 0; e < 12; e++) acc[e] = 0.f;
    const float* wp = p.ada_w + ((size_t)l * 1024 + slice * 32) * 3072 + col0 + cl * 4;
#pragma unroll 16
    for (int kk = 0; kk < 32; kk++) {
        const float4 wv = ld_nt4(wp + (size_t)kk * 3072);
        const int k = slice * 32 + kk;
        const float s0 = sc[k], s1 = sc[1024 + k], s2 = sc[2048 + k];
        acc[0] += s0 * wv.x; acc[1] += s0 * wv.y; acc[2] += s0 * wv.z; acc[3] += s0 * wv.w;
        acc[4] += s1 * wv.x; acc[5] += s1 * wv.y; acc[6] += s1 * wv.z; acc[7] += s1 * wv.w;
        acc[8] += s2 * wv.x; acc[9] += s2 * wv.y; acc[10] += s2 * wv.z; acc[11] += s2 * wv.w;
    }
#pragma unroll
    for (int e = 0; e < 12; e++) red[tid * 12 + e] = acc[e];
    __syncthreads();
    if (tid < 96) {
        const int v = tid >> 5, cc = tid & 31, c4 = cc >> 2, e = cc & 3;
        float s = 0.f;
        for (int sl = 0; sl < 32; sl++) s += red[(sl * 8 + c4) * 12 + v * 4 + e];
        s += p.ada_b[l * 3072 + col0 + cc];
        p.mod[(l * 3 + v) * 3072 + col0 + cc] = s;
    }
    __syncthreads();
}

struct ConvDesc { const float* src; bf16_t* dst; int ld_src, ld_dst, r0, c0; bool transpose; };
__device__ __forceinline__ ConvDesc conv_decode(const Params& p, int j) {
    ConvDesc d;
    if (j < 640) {
        const int i = j / 320, tt = j % 320, kt2 = tt / 40, nt = tt % 40;
        d.src = p.even_w_in + (size_t)i * 1024 * 2560; d.ld_src = 2560; d.dst = p.winT_e + (size_t)i * 2560 * LDK; d.ld_dst = LDK; d.r0 = kt2 * 128; d.c0 = nt * 64; d.transpose = true;
        return d;
    }
    j -= 640;
    const int kind = j >> 8, jj = j & 255, i = jj >> 7, tt = jj & 127, kt2 = tt >> 4, nt = tt & 15;
    d.ld_dst = LDK; d.r0 = kt2 * 128; d.c0 = nt * 64; d.transpose = true;
    if (kind == 0) { d.src = p.even_w_out + (size_t)i * 1048576; d.ld_src = 1024; d.dst = p.woutT_e + (size_t)i * 1024 * LDK; }
    else if (kind == 1) { d.src = p.odd_w_out + (size_t)i * 1048576; d.ld_src = 1024; d.dst = p.woutT_o + (size_t)i * 1024 * LDK; }
    else if (kind == 2) { d.src = p.odd_w_in + (size_t)i * 1024 * 2048 + 1024; d.ld_src = 2048; d.dst = p.wfT + (size_t)i * WF_ROWS * LDK + (size_t)1024 * LDK; }
    else { d.src = p.odd_w_in + (size_t)i * 1024 * 2048; d.ld_src = 2048; d.dst = p.wu + (size_t)i * 1024 * LDK; d.transpose = false; }
    return d;
}
__device__ __forceinline__ void conv_load(const ConvDesc& d, int tid, float4 (&v)[8]) {
#pragma unroll
    for (int i = 0; i < 8; i++) {
        const int idx = tid + 256 * (i & 3), rr = (idx >> 4) + 64 * (i >> 2), c4 = idx & 15;
        v[i] = ld_nt4(d.src + (size_t)(d.r0 + rr) * d.ld_src + d.c0 + c4 * 4);
    }
}
__device__ __forceinline__ void conv_finish(const ConvDesc& d, int tid, const float4 (&v)[8], char* smem) {
    float* T = (float*)smem;
    if (!d.transpose) {
#pragma unroll
        for (int i = 0; i < 8; i++) {
            const int idx = tid + 256 * (i & 3), rr = (idx >> 4) + 64 * (i >> 2), c4 = idx & 15;
            uint2 u; u.x = pack2(v[i].x, v[i].y); u.y = pack2(v[i].z, v[i].w);
            *(uint2*)(d.dst + (size_t)(d.r0 + rr) * d.ld_dst + d.c0 + c4 * 4) = u;
        }
        return;
    }
#pragma unroll
    for (int hf = 0; hf < 2; hf++) {
#pragma unroll
        for (int i = 0; i < 4; i++) {
            const int idx = tid + 256 * i, rr = idx >> 4, c4 = idx & 15;
            T[rr * 65 + c4 * 4 + 0] = v[hf * 4 + i].x; T[rr * 65 + c4 * 4 + 1] = v[hf * 4 + i].y;
            T[rr * 65 + c4 * 4 + 2] = v[hf * 4 + i].z; T[rr * 65 + c4 * 4 + 3] = v[hf * 4 + i].w;
        }
        __syncthreads();
        {
            const int n = tid >> 2, kq = tid & 3;
            float f[16];
#pragma unroll
            for (int e = 0; e < 16; e++) f[e] = T[(kq * 16 + e) * 65 + n];
            uint4 u0, u1;
            u0.x = pack2(f[0], f[1]); u0.y = pack2(f[2], f[3]); u0.z = pack2(f[4], f[5]); u0.w = pack2(f[6], f[7]);
            u1.x = pack2(f[8], f[9]); u1.y = pack2(f[10], f[11]); u1.z = pack2(f[12], f[13]); u1.w = pack2(f[14], f[15]);
            bf16_t* dd = d.dst + (size_t)(d.c0 + n) * d.ld_dst + d.r0 + hf * 64 + kq * 16;
            *(uint4*)dd = u0; *(uint4*)(dd + 8) = u1;
        }
        __syncthreads();
    }
}

__device__ void phase_p0a(const Params& p, char* smem) {
    const int total = 384 + 640 + 4 * 256;
    {
        const int tid = tid_l();
        int item = blockIdx.x;
        if (item < 384) { ada_item(p, item, smem); item += gridDim.x; }
        float4 cur[8], nxt[8];
        if (item < total) { const ConvDesc d0 = conv_decode(p, item - 384); conv_load(d0, tid, cur); }
#pragma unroll 1
        while (item < total) {
            const int nitem = item + gridDim.x;
            if (nitem < total) { const ConvDesc dn = conv_decode(p, nitem - 384); conv_load(dn, tid, nxt); }
            const ConvDesc dc = conv_decode(p, item - 384);
            conv_finish(dc, tid, cur, smem);
#pragma unroll
            for (int i = 0; i < 8; i++) cur[i] = nxt[i];
            item = nitem;
        }
    }
    const int gt = blockIdx.x * 256 + tid_l(), gs = gridDim.x * 256;
    for (int e = gt; e < 65536; e += gs) {
        const int m = e >> 8, c = e & 255;
        const float x = 2.0f * (float)((m * c) & 255) * (1.0f / 256.0f);
        p.Cc[m * LDC + c] = f2bf(cospif(x) * 0.0625f);
        p.Sc[m * LDC + c] = f2bf((m == 0 ? ((c & 1) ? -1.0f : 1.0f) : sinpif(x)) * 0.0625f);
    }
    for (int e = gt; e < 256 * 512; e += gs) {
        const int k = e >> 9, kk = e & 511, s = kk & 255;
        const float x = 2.0f * (float)((k * s) & 255) * (1.0f / 256.0f);
        p.D256[k * LDD2 + kk] = f2bf((kk < 256 ? cospif(x) : -sinpif(x)) * 0.0625f);
    }
    for (int e = gt; e < 1024 * 2048; e += gs) {
        const int k = e >> 11, kk = e & 2047, s = kk & 1023;
        const float x = 2.0f * (float)((k * s) & 1023) * (1.0f / 1024.0f);
        p.D1024[(size_t)k * LDD1 + kk] = f2bf((kk < 1024 ? cospif(x) : -sinpif(x)) * 0.03125f);
    }
    for (int e = gt; e < 1024 * 32; e += gs) {
        const int pos = e >> 5, j = e & 31, f = j & 15;
        const float idx = (float)((j < 16) ? (pos >> 6) : (pos & 63));
        const float inv = 1.0f / powf(10000.0f, (float)f * (1.0f / 16.0f));
        const float ang = idx * inv;
        const float xpi = ang * 0.31830988618379067f;
        p.rope[e] = make_float2(cospif(xpi), sinpif(xpi));
    }
    for (int e = gt; e < 2 * 2 * 2 * 2 * 256 * 64; e += gs) {
        const int d = e & 63, pos = (e >> 6) & 255, kvh = (e >> 14) & 1, mixer = (e >> 15) & 1, bi = e >> 16;
        const float* ck = mixer ? p.cache_k_b : p.cache_k_a;
        const float* cv = mixer ? p.cache_v_b : p.cache_v_a;
        const size_t src = ((size_t)bi * 256 + pos) * 128 + kvh * 64 + d;
        p.cK[e] = f2bf(ck[src]);
        const int ci = (bi * 2 + mixer) * 2 + kvh;
        p.cVT[((size_t)ci * 64 + d) * 256 + pos] = f2bf(cv[src]);
    }
}

__device__ void phase_norm(const Params& p, int l  ) {
    const int tidn = tid_l();
    const int lane = tidn & 63;
    const int gw = blockIdx.x * 4 + (tidn >> 6), nw = gridDim.x * 4;
    for (int t0 = gw; t0 < NTOK; t0 += 2 * nw) {
        int tt[2]; tt[0] = t0; tt[1] = (t0 + nw < NTOK) ? t0 + nw : t0;
        float4 v[2][4];
        float ss[2];
#pragma unroll
        for (int u = 0; u < 2; u++) {
            const int t = tt[u];
            const float* src = (l == 0) ? (t < NCTX ? p.x_prompt + (size_t)t * DM : p.x_sample + (size_t)(t - NCTX) * DM) : p.out + (size_t)t * DM;
#pragma unroll
            for (int i = 0; i < 4; i++) v[u][i] = *(const float4*)(src + i * 256 + lane * 4);
        }
#pragma unroll
        for (int u = 0; u < 2; u++) {
            float s = 0.f;
#pragma unroll
            for (int i = 0; i < 4; i++) s += v[u][i].x * v[u][i].x + v[u][i].y * v[u][i].y + v[u][i].z * v[u][i].z + v[u][i].w * v[u][i].w;
#pragma unroll
            for (int o = 32; o >= 1; o >>= 1) s += __shfl_xor(s, o);
            ss[u] = s;
        }
#pragma unroll
        for (int u = 0; u < 2; u++) {
            const int t = tt[u];
            const float rstd = rsqrtf(ss[u] * (1.0f / 1024.0f) + 1e-6f);
            if (l < 4) {
                const int mv = (t < NCTX) ? 0 : 1 + ((t - NCTX) >> 10);
                const float* shift = p.mod + (size_t)(l * 3 + mv) * 3072;
                const float* scale = shift + 1024;
                const float* g = p.norm_g + l * 1024;
#pragma unroll
                for (int i = 0; i < 4; i++) {
                    const int col = i * 256 + lane * 4;
                    const float4 gg = *(const float4*)(g + col), sh = *(const float4*)(shift + col), sc = *(const float4*)(scale + col);
                    const float y0 = v[u][i].x * rstd * gg.x * (1.f + sc.x) + sh.x;
                    const float y1 = v[u][i].y * rstd * gg.y * (1.f + sc.y) + sh.y;
                    const float y2 = v[u][i].z * rstd * gg.z * (1.f + sc.z) + sh.z;
                    const float y3 = v[u][i].w * rstd * gg.w * (1.f + sc.w) + sh.w;
                    uint2 uu; uu.x = pack2(y0, y1); uu.y = pack2(y2, y3);
                    *(uint2*)(p.h + (size_t)t * LDK + col) = uu;
                }
            } else {
                const float* g = p.final_g;
#pragma unroll
                for (int i = 0; i < 4; i++) {
                    const int col = i * 256 + lane * 4;
                    const float4 gg = *(const float4*)(g + col);
                    *(float4*)(p.out + (size_t)t * DM + col) = make_float4(v[u][i].x * rstd * gg.x, v[u][i].y * rstd * gg.y, v[u][i].z * rstd * gg.z, v[u][i].w * rstd * gg.w);
                }
            }
        }
    }
}

__device__ void phase_p0b(const Params& p, char* smem, int slot) {
    const int tid = tid_l();
    int q_ = 0; const int myx = xcc_id_hw() & 7; int* ctr = p.ctr + slot * CTR_SLOT_WORDS;
    volatile int* s_item = (volatile int*)(smem + SMEM_BYTES);
    for (;;) {
        const int tk = tq_next(ctr, 16, myx, q_, s_item, tid);
        if (tk < 0) break;
        const int idx = (tk >> 16) * 16 + (tk & 0xffff);
        const int nt = idx & 7, g = (idx >> 3) & 3, trig = (idx >> 5) & 1, l = idx >> 6;
        const bf16_t* A = (trig ? p.Sc : p.Cc);
        const bf16_t* Bt = p.wu + (size_t)l * 1024 * LDK + (size_t)(nt * 128) * LDK + g * 256;
        gemm_core(A, LDC, Bt, Bt, 1 << 30, LDK, 256, smem);
        const float* Cs = (const float*)smem;
        const int row = tid >> 1, half = tid & 1;
        float v[64];
        cs_read_row(Cs, row, half, v);
        bf16_t* dst = p.wfT + (size_t)l * WF_ROWS * LDK + (size_t)(trig * 512 + g * 128 + row) * LDK + nt * 128 + half * 64;
        store_row_bf16(dst, v);
    }
    phase_norm(p, 0);
}

__device__ void phase_g1_even(const Params& p, int i, char* smem, int slot) {
    if (i == 0) compute_shiftW(p);
    const int tid = tid_l();
    const int NT = 20, total = 80 * NT;
    int q_ = 0; const int myx = xcc_id_hw() & 7; int* ctr = p.ctr + slot * CTR_SLOT_WORDS;
    volatile int* s_item = (volatile int*)(smem + SMEM_BYTES);
    for (;;) {
        const int tk = tq_next(ctr, total / 8, myx, q_, s_item, tid);
        if (tk < 0) break;
        const int xq = tk >> 16, idx = tk & 0xffff;
        const int mt = (xq >> 1) + 4 * (idx / (NT / 2)), nt = (xq & 1) * (NT / 2) + idx % (NT / 2), m0 = mt * 128;
        const bf16_t* A = p.h + (size_t)m0 * LDK;
        const bf16_t* Bt = p.winT_e + (size_t)i * 2560 * LDK + (size_t)(nt * 128) * LDK;
        float pre = 0.f;
        if (i > 0) pre = aff_prefetch(p, 2 * i, m0, nt * 128, tid);
        gemm_core(A, LDK, Bt, Bt, 1 << 30, LDK, 1024, smem);
        if (i > 0) aff_publish(smem, pre, tid);
        const float* aff = (i > 0) ? (const float*)(smem + AFF_OFF) : nullptr;
        const float* Cs = (const float*)smem;
        int seg;
        if (nt < 4) seg = 0; else if (nt == 4) seg = 1; else if (nt == 5) seg = 2; else if (nt < 10) seg = 3;
        else if (nt < 14) seg = 4; else if (nt == 14) seg = 5; else if (nt == 15) seg = 6; else seg = 7;
        const bool lat = m0 >= NCTX;
        const int row = tid >> 1, half = tid & 1;
        const int t = m0 + row;
        float v[64];
        cs_read_row(Cs, row, half, v);
        if (i > 0) aff_apply_row(smem, row, half, v);
        if (seg == 0 || seg == 1) {
            float ss = 0.f;
#pragma unroll
            for (int d = 0; d < 64; d++) ss += v[d] * v[d];
            const float rs = rsqrtf(ss * (1.0f / 64.0f) + 1e-6f);
            const float* g = (seg == 0 ? p.qk_g_q : p.qk_g_k) + i * 64;
#pragma unroll
            for (int d = 0; d < 64; d++) v[d] = v[d] * rs * g[d];
        }
        if (!lat && (seg == 1 || seg == 2 || seg == 5 || seg == 6)) {
            const int b = t >> 8, s = t & 255;
            const size_t off = (seg == 1 ? 10485760u : seg == 2 ? 12582912u : seg == 5 ? 14680064u : 16777216u);
            float* dst = p.out + off + ((size_t)(b * 2 + i) * 256 + s) * 128 + half * 64;
            store_row_f32(dst, v);
        }
        if (lat && (seg == 0 || seg == 1 || seg == 4 || seg == 5)) {
            const int pos = (t - NCTX) & 1023;
            const float2* rp = p.rope + pos * 32;
#pragma unroll
            for (int pp = 0; pp < 2; pp++)
#pragma unroll
                for (int f = 0; f < 16; f++) {
                    const float2 cs = rp[pp * 16 + f];
                    const float x1 = v[pp * 32 + f], x2 = v[pp * 32 + 16 + f];
                    v[pp * 32 + f] = x1 * cs.x - x2 * cs.y;
                    v[pp * 32 + 16 + f] = x2 * cs.x + x1 * cs.y;
                }
        }
        if (seg == 0 || seg == 4) {
#pragma unroll
            for (int d = 0; d < 64; d++) v[d] *= 0.18033688011112042f;
        }
        if (seg == 3 || seg == 7) {
#pragma unroll
            for (int d = 0; d < 64; d++) v[d] = silu_f(v[d]);
        }
        if (seg == 2 || seg == 6) {
            const int col = tid & 127, rgrp = tid >> 7, kvh = col >> 6, d = col & 63, mixer = (seg == 6);
            const int t0 = m0 + rgrp * 64;
            bf16_t* dst;
            if (!lat) { const int b = t0 >> 8, s = t0 & 255; dst = p.vT_ctx + ((size_t)(((b * 2 + mixer) * 2 + kvh) * 64 + d)) * 256 + s; }
            else { const int tl = t0 - NCTX, b = tl >> 10, s = tl & 1023; dst = p.vT_lat + ((size_t)(((b * 2 + mixer) * 2 + kvh) * 64 + d)) * 1024 + s; }
            cs_store_col(Cs, col, rgrp, dst - rgrp * 64, aff);
        } else {
            store_row_bf16(p.R + (size_t)t * 2560 + nt * 128 + half * 64, v);
        }
    }
}

__device__ __forceinline__ void cs_store_col2(const float* Cs, int col, int rgrp, bf16_t* dst1, bf16_t* dst2, unsigned flip, const float* aff) {
    const float sw = aff[128 + col];
#pragma unroll
    for (int ch = 0; ch < 8; ch++) {
        const int r0 = rgrp * 64 + ch * 8;
        float f[8];
#pragma unroll
        for (int e = 0; e < 8; e++) f[e] = Cs[(r0 + e) * CS_LD + col] * aff[r0 + e] + sw;
        u32x4 u;
        u[0] = pack2(f[0], f[1]); u[1] = pack2(f[2], f[3]); u[2] = pack2(f[4], f[5]); u[3] = pack2(f[6], f[7]);
        *(u32x4*)(dst1 + r0) = u;
        if (dst2) { u32x4 w = u; w[0] ^= flip; w[1] ^= flip; w[2] ^= flip; w[3] ^= flip; *(u32x4*)(dst2 + r0) = w; }
    }
}
__device__ void phase_g1_odd(const Params& p, int i, char* smem, int slot) {
    const int tid = tid_l();
    const int NT = 16, total = 80 * NT;
    bf16_t* UT = p.R;
    bf16_t* gbuf = p.R + (size_t)2048 * LDU;
    int q_ = 0; const int myx = xcc_id_hw() & 7; int* ctr = p.ctr + slot * CTR_SLOT_WORDS;
    volatile int* s_item = (volatile int*)(smem + SMEM_BYTES);
    for (;;) {
        const int tk = tq_next(ctr, 160, myx, q_, s_item, tid);
        if (tk < 0) break;
        const int xq = tk >> 16, idx = tk & 0xffff;
        const int mt = (xq >> 1) + 4 * (idx >> 3), nt = (xq & 1) * 8 + (idx & 7), m0 = mt * 128;
        const bf16_t* A = p.h + (size_t)m0 * LDK;
        const bf16_t* Bt = p.wfT + (size_t)i * WF_ROWS * LDK + (size_t)(nt * 128) * LDK;
        const float pre = aff_prefetch(p, 2 * i + 1, m0, nt * 128, tid);
        gemm_core(A, LDK, Bt, Bt, 1 << 30, LDK, 1024, smem);
        aff_publish(smem, pre, tid);
        const float* aff = (const float*)(smem + AFF_OFF);
        const float* Cs = (const float*)smem;
        if (nt < 8) {
            const int col = tid & 127, rgrp = tid >> 7, g = nt & 3, sinp = nt >> 2;
            bf16_t* base = UT + (size_t)(sinp * 1024 + g * 256) * LDU + m0;
            if (col >= 1) cs_store_col2(Cs, col, rgrp, base + (size_t)col * LDU, base + (size_t)(256 - col) * LDU, sinp ? 0x80008000u : 0u, aff);
            else if (!sinp) cs_store_col2(Cs, 0, rgrp, base, nullptr, 0u, aff);
            else {
                cs_store_col2(Cs, 0, rgrp, UT + (size_t)(g * 256 + 128) * LDU + m0, nullptr, 0u, aff);
                u32x4 zz; zz[0] = 0u; zz[1] = 0u; zz[2] = 0u; zz[3] = 0u;
                bf16_t* z0 = base + rgrp * 64;
                bf16_t* z1 = base + (size_t)128 * LDU + rgrp * 64;
#pragma unroll
                for (int ch = 0; ch < 8; ch++) { *(u32x4*)(z0 + ch * 8) = zz; *(u32x4*)(z1 + ch * 8) = zz; }
            }
        } else {
            const int row = tid >> 1, half = tid & 1;
            float v[64];
            cs_read_row(Cs, row, half, v);
            aff_apply_row(smem, row, half, v);
#pragma unroll
            for (int d = 0; d < 64; d++) v[d] = silu_f(v[d]);
            store_row_bf16(gbuf + (size_t)(m0 + row) * DM + (nt - 8) * 128 + half * 64, v);
        }
    }
}

__device__ void phase_f2(const Params& p, int i, char* smem, int slot) {
    const int tid = tid_l();
    bf16_t* UT = p.R;
    bf16_t* gbuf = p.R + (size_t)2048 * LDU;
    int q_ = 0; const int myx = xcc_id_hw() & 7; int* ctr = p.ctr + slot * CTR_SLOT_WORDS;
    volatile int* s_item = (volatile int*)(smem + SMEM_BYTES);
    for (;;) {
        const int tk = tq_next(ctr, 80, myx, q_, s_item, tid);
        if (tk < 0) break;
        const int xq = tk >> 16, idx = tk & 0xffff;
        int seq_base, S, mt, nt, ldd;
        const bf16_t* D;
        if (idx < 16) { const int b = xq >> 2; nt = (xq & 3) * 2 + (idx >> 3); mt = idx & 7; seq_base = NCTX + b * 1024; S = 1024; D = p.D1024; ldd = LDD1; }
        else { const int j = idx - 16; const int b = xq * 4 + (j >> 4); mt = (j >> 3) & 1; nt = j & 7; seq_base = b * 256; S = 256; D = p.D256; ldd = LDD2; }
        const bf16_t* A = D + (size_t)(mt * 128) * ldd;
        const bf16_t* B0 = UT + (size_t)(nt * 128) * LDU + seq_base;
        const bf16_t* B1 = UT + (size_t)(1024 + nt * 128) * LDU + seq_base;
        gemm_core(A, ldd, B0, B1, S, LDU, 2 * S, smem);
        const float* Cs = (const float*)smem;
        const int row = tid >> 1, half = tid & 1;
        const int tok = seq_base + mt * 128 + row;
        float v[64];
        cs_read_row(Cs, row, half, v);
        const bf16_t* gp = gbuf + (size_t)tok * DM + nt * 128 + half * 64;
#pragma unroll
        for (int j = 0; j < 8; j++) {
            const uint4 g = *(const uint4*)(gp + 8 * j);
            v[8 * j + 0] *= bf_lo(g.x); v[8 * j + 1] *= bf_hi(g.x);
            v[8 * j + 2] *= bf_lo(g.y); v[8 * j + 3] *= bf_hi(g.y);
            v[8 * j + 4] *= bf_lo(g.z); v[8 * j + 5] *= bf_hi(g.z);
            v[8 * j + 6] *= bf_lo(g.w); v[8 * j + 7] *= bf_hi(g.w);
        }
        store_row_bf16(p.mix + (size_t)tok * LDK + nt * 128 + half * 64, v);
    }
}

__device__ void phase_g2(const Params& p, int l, char* smem, int slot) {
    const int tid = tid_l();
    const int NT = 8, total = 80 * NT;
    const bf16_t* WT = ((l & 1) ? p.woutT_o : p.woutT_e) + (size_t)(l >> 1) * 1024 * LDK;
    int q_ = 0; const int myx = xcc_id_hw() & 7; int* ctr = p.ctr + slot * CTR_SLOT_WORDS;
    volatile int* s_item = (volatile int*)(smem + SMEM_BYTES);
    for (;;) {
        const int tk = tq_next(ctr, total / 8, myx, q_, s_item, tid);
        if (tk < 0) break;
        const int xq = tk >> 16, idx = tk & 0xffff;
        const int mt = xq + 8 * (idx >> 3), nt = idx & 7, m0 = mt * 128;
        const bf16_t* A = p.mix + (size_t)m0 * LDK;
        const bf16_t* Bt = WT + (size_t)(nt * 128) * LDK;
        gemm_core(A, LDK, Bt, Bt, 1 << 30, LDK, 1024, smem);
        const float* Cs = (const float*)smem;
        const int row = tid >> 1, half = tid & 1;
        const int t = m0 + row, c0 = nt * 128 + half * 64;
        float v[64];
        cs_read_row(Cs, row, half, v);
        const int mv = (t < NCTX) ? 0 : 1 + ((t - NCTX) >> 10);
        const float* gate = p.mod + (size_t)(l * 3 + mv) * 3072 + 2048 + c0;
        const float* xs = (l == 0) ? (t < NCTX ? p.x_prompt + (size_t)t * DM : p.x_sample + (size_t)(t - NCTX) * DM) : p.out + (size_t)t * DM;
        xs += c0;
        float* xo = p.out + (size_t)t * DM + c0;
#pragma unroll
        for (int c = 0; c < 2; c++) {
            float4 xv[8], gv[8];
#pragma unroll
            for (int j = 0; j < 8; j++) { xv[j] = *(const float4*)(xs + 32 * c + 4 * j); gv[j] = *(const float4*)(gate + 32 * c + 4 * j); }
#pragma unroll
            for (int j = 0; j < 8; j++) {
                const int o = 32 * c + 4 * j;
                v[o] = xv[j].x + gv[j].x * v[o]; v[o + 1] = xv[j].y + gv[j].y * v[o + 1];
                v[o + 2] = xv[j].z + gv[j].z * v[o + 2]; v[o + 3] = xv[j].w + gv[j].w * v[o + 3];
                *(float4*)(xo + o) = make_float4(v[o], v[o + 1], v[o + 2], v[o + 3]);
            }
        }
        if (l < 3) {
            float ss = 0.f;
#pragma unroll
            for (int d = 0; d < 64; d++) ss += v[d] * v[d];
            ss += __shfl_xor(ss, 1);
            if (half == 0) p.part[(size_t)nt * NTOK + t] = ss;
            const float* ng = p.norm_g + (l + 1) * 1024 + c0;
            const float* sc = p.mod + (size_t)((l + 1) * 3 + mv) * 3072 + 1024 + c0;
#pragma unroll
            for (int j = 0; j < 16; j++) {
                const float4 g4 = *(const float4*)(ng + 4 * j), s4 = *(const float4*)(sc + 4 * j);
                v[4 * j] *= g4.x * (1.f + s4.x); v[4 * j + 1] *= g4.y * (1.f + s4.y);
                v[4 * j + 2] *= g4.z * (1.f + s4.z); v[4 * j + 3] *= g4.w * (1.f + s4.w);
            }
            store_row_bf16(p.h + (size_t)t * LDK + c0, v);
        }
    }
}

#define KS_LD 72
#define VS_LD 68
#define VF_LD 260
#define ATT_TILE(KB_, KROWS_, VB_, VROWS_, DO_MASK_, KBASE_) { \
            f32x16 X[2]; \
            _Pragma("unroll") \
            for (int e = 0; e < 16; e++) { X[0][e] = 0.f; X[1][e] = 0.f; } \
            _Pragma("unroll") \
            for (int ks = 0; ks < 4; ks++) { \
                bf16x8 k0 = *(const bf16x8*)((KB_) + ks * 16); \
                bf16x8 k1 = *(const bf16x8*)((KB_) + 32 * (KROWS_) + ks * 16); \
                X[0] = __builtin_amdgcn_mfma_f32_32x32x16_bf16(k0, qf[ks], X[0], 0, 0, 0); \
                X[1] = __builtin_amdgcn_mfma_f32_32x32x16_bf16(k1, qf[ks], X[1], 0, 0, 0); \
            } \
            if (DO_MASK_) { \
                _Pragma("unroll") \
                for (int kt = 0; kt < 2; kt++) \
                    _Pragma("unroll") \
                    for (int e = 0; e < 16; e++) { \
                        const int rel = (KBASE_) + 32 * kt + (e & 3) + 8 * (e >> 2); \
                        if (rel > 128 || rel < -128) X[kt][e] = -1e30f; \
                    } \
            } \
            float mloc = fmaxf(X[0][0], X[1][0]); \
            _Pragma("unroll") \
            for (int e = 1; e < 16; e++) mloc = fmaxf(fmaxf(X[0][e], X[1][e]), mloc); \
            mloc = fmaxf(mloc, __shfl_xor(mloc, 32)); \
            const float m_new = fmaxf(m_run, mloc); \
            if (__builtin_amdgcn_ballot_w64(m_new != m_run) != 0ull) {        \
                const float alpha = __builtin_amdgcn_exp2f(m_run - m_new); \
                l_run *= alpha; \
                _Pragma("unroll") \
                for (int e = 0; e < 16; e++) { O[0][e] *= alpha; O[1][e] *= alpha; } \
                m_run = m_new; \
            } \
            float psum = 0.f; \
            _Pragma("unroll") \
            for (int kt = 0; kt < 2; kt++) \
                _Pragma("unroll") \
                for (int e = 0; e < 16; e++) { const float pv = __builtin_amdgcn_exp2f(X[kt][e] - m_new); X[kt][e] = pv; psum += pv; } \
            l_run += psum; \
            _Pragma("unroll") \
            for (int kt = 0; kt < 2; kt++) \
                _Pragma("unroll") \
                for (int s = 0; s < 2; s++) { \
                    u32x4 pbu; \
                    pbu[0] = pack2(X[kt][8 * s + 0], X[kt][8 * s + 1]); \
                    pbu[1] = pack2(X[kt][8 * s + 2], X[kt][8 * s + 3]); \
                    pbu[2] = pack2(X[kt][8 * s + 4], X[kt][8 * s + 5]); \
                    pbu[3] = pack2(X[kt][8 * s + 6], X[kt][8 * s + 7]); \
                    const bf16x8 pbv = (bf16x8)pbu; \
                    _Pragma("unroll") \
                    for (int dm = 0; dm < 2; dm++) { \
                        const bf16_t* vp = (VB_) + dm * 32 * (VROWS_) + 32 * kt + 16 * s; \
                        const u32x2 va0 = *(const u32x2*)(vp); \
                        const u32x2 va1 = *(const u32x2*)(vp + 8); \
                        u32x4 vau; \
                        vau[0] = va0[0]; vau[1] = va0[1]; vau[2] = va1[0]; vau[3] = va1[1]; \
                        O[dm] = __builtin_amdgcn_mfma_f32_32x32x16_bf16((bf16x8)vau, pbv, O[dm], 0, 0, 0); \
                    } \
                } \
        }
#define ATT_STORE(TQ_, GCOL_, MIXCOL_) { \
            const float l_tot = l_run + __shfl_xor(l_run, 32); \
            const float inv = 1.0f / l_tot; \
            const bf16_t* gp = p.R + (size_t)(TQ_) * 2560 + (GCOL_); \
            bf16_t* op = p.mix + (size_t)(TQ_) * LDK + (MIXCOL_); \
            _Pragma("unroll") \
            for (int dm = 0; dm < 2; dm++) \
                _Pragma("unroll") \
                for (int g4 = 0; g4 < 4; g4++) { \
                    const int d0 = dm * 32 + 8 * g4 + 4 * hh; \
                    const uint2 g = *(const uint2*)(gp + d0); \
                    const float o0 = O[dm][4 * g4 + 0] * inv * bf_lo(g.x); \
                    const float o1 = O[dm][4 * g4 + 1] * inv * bf_hi(g.x); \
                    const float o2 = O[dm][4 * g4 + 2] * inv * bf_lo(g.y); \
                    const float o3 = O[dm][4 * g4 + 3] * inv * bf_hi(g.y); \
                    uint2 u; u.x = pack2(o0, o1); u.y = pack2(o2, o3); \
                    *(uint2*)(op + d0) = u; \
                } \
        }

__device__ void phase_attn(const Params& p, int i, char* smem, int slot) {
    const int tid = tid_l(), lane = tid & 63, w = tid >> 6, r = lane & 31, hh = lane >> 5;
    bf16_t* Ks = (bf16_t*)smem;
    bf16_t* Vs = Ks + 2 * 64 * KS_LD;
    bf16_t* Vf = Ks + 256 * KS_LD;
    int q_ = 0; const int myx = xcc_id_hw() & 7; int* ctr = p.ctr + slot * CTR_SLOT_WORDS;
    volatile int* s_item = (volatile int*)(smem + SMEM_BYTES);
    for (;;) {
        const int tk = tq_next(ctr, 64, myx, q_, s_item, tid);
        if (tk < 0) break;
        const int xq = tk >> 16, idx = tk & 0xffff;
        if (idx >= 32) {
            const int j = idx - 32;
            const int b = xq * 4 + (j >> 3), mixer = (j >> 2) & 1, kvh = (j >> 1) & 1, pair = j & 1;
            const int kcol = (mixer ? 1792 : 512) + kvh * 64;
            const bf16_t* Kg = p.R + (size_t)(b * 256) * 2560 + kcol;
            const bf16_t* Vg = p.vT_ctx + (size_t)(((b * 2 + mixer) * 2 + kvh) * 64) * 256;
            {
                u32x4 kk[8], vv[8];
#pragma unroll
                for (int c = 0; c < 8; c++) {
                    const int ci = tid + 256 * c;
                    kk[c] = *(const u32x4*)(Kg + (size_t)(ci >> 3) * 2560 + (ci & 7) * 8);
                    vv[c] = *(const u32x4*)(Vg + (size_t)(ci >> 5) * 256 + (ci & 31) * 8);
                }
#pragma unroll
                for (int c = 0; c < 8; c++) {
                    const int ci = tid + 256 * c;
                    *(u32x4*)(Ks + (ci >> 3) * KS_LD + (ci & 7) * 8) = kk[c];
                    u32x2* vd = (u32x2*)(Vf + (ci >> 5) * VF_LD + (ci & 31) * 8);
                    vd[0] = vv[c].xy; vd[1] = vv[c].zw;
                }
            }
            __syncthreads();
#pragma unroll 1
            for (int sub = 0; sub < 4; sub++) {
                const int head = kvh * 4 + pair * 2 + (sub >> 1), qb = sub & 1;
                const int tq = b * 256 + qb * 128 + w * 32 + r;
                bf16x8 qf[4];
                {
                    const bf16_t* qp = p.R + (size_t)tq * 2560 + (mixer ? 1280 : 0) + head * 64 + hh * 8;
#pragma unroll
                    for (int ks = 0; ks < 4; ks++) qf[ks] = *(const bf16x8*)(qp + ks * 16);
                }
                float m_run, l_run;
                if (mixer) { m_run = p.sink[i * 8 + head] * 1.4426950408889634f; l_run = hh ? 0.f : 1.f; } else { m_run = -1e30f; l_run = 0.f; }
                f32x16 O[2];
#pragma unroll
                for (int e = 0; e < 16; e++) { O[0][e] = 0.f; O[1][e] = 0.f; }
#pragma unroll 1
                for (int jt = 0; jt < 4; jt++) {
                    const bf16_t* kb = Ks + (jt * 64 + r) * KS_LD + hh * 8;
                    const bf16_t* vb = Vf + r * VF_LD + jt * 64 + 4 * hh;
                    ATT_TILE(kb, KS_LD, vb, VF_LD, false, 0);
                }
                ATT_STORE(tq, (mixer ? 2048 : 768) + head * 64, mixer * 512 + head * 64);
            }
            __syncthreads();
            continue;
        }
        const int mixer = idx >> 4, b = xq >> 2, head = ((xq >> 1) & 1) * 4 + (xq & 1) * 2 + ((idx >> 3) & 1), qb = idx & 7;
        const int kvh = head >> 2;
        const int tq0 = NCTX + b * 1024 + qb * 128;
        const int qcol = (mixer ? 1280 : 0) + head * 64, kcol = (mixer ? 1792 : 512) + kvh * 64, gcol = (mixer ? 2048 : 768) + head * 64;
        int klo = 0, khi = 1024;
        if (mixer) { klo = (qb - 1) * 128; if (klo < 0) klo = 0; khi = (qb + 2) * 128; if (khi > 1024) khi = 1024; }
        const bf16_t* K0 = p.R + (size_t)(NCTX + b * 1024 + klo) * 2560 + kcol; const int ks0 = 2560;
        const bf16_t* V0 = p.vT_lat + (size_t)(((b * 2 + mixer) * 2 + kvh) * 64) * 1024 + klo; const int vs0 = 1024;
        const int nt0 = (khi - klo) >> 6, kpos0 = klo;
        const int ci = ((b * 2 + i) * 2 + mixer) * 2 + kvh;
        const bf16_t* K1 = p.cK + (size_t)ci * 256 * 64; const bf16_t* V1 = p.cVT + (size_t)ci * 64 * 256;
        const bool masked = mixer != 0;
        const int ntiles = nt0 + 4;
        bf16x8 qf[4];
        {
            const bf16_t* qp = p.R + (size_t)(tq0 + w * 32 + r) * 2560 + qcol + hh * 8;
#pragma unroll
            for (int ks = 0; ks < 4; ks++) qf[ks] = *(const bf16x8*)(qp + ks * 16);
        }
        float m_run, l_run;
        if (mixer) { m_run = p.sink[i * 8 + head] * 1.4426950408889634f; l_run = hh ? 0.f : 1.f; } else { m_run = -1e30f; l_run = 0.f; }
        f32x16 O[2];
#pragma unroll
        for (int e = 0; e < 16; e++) { O[0][e] = 0.f; O[1][e] = 0.f; }
        const int qpos = qb * 128 + w * 32 + r;

        u32x4 gk0, gk1, gv0, gv1;
        const int lrow = tid >> 3, lkc = tid & 7;
#define ATT_GLOAD(J) { \
            const bf16_t *Kp_, *Vp_; int kst_, vst_; \
            if ((J) < nt0) { Kp_ = K0 + (size_t)((J) * 64) * ks0; kst_ = ks0; Vp_ = V0 + (J) * 64; vst_ = vs0; } \
            else { Kp_ = K1 + (size_t)(((J) - nt0) * 64) * 64; kst_ = 64; Vp_ = V1 + ((J) - nt0) * 64; vst_ = 256; } \
            gk0 = *(const u32x4*)(Kp_ + (size_t)lrow * kst_ + lkc * 8); \
            gk1 = *(const u32x4*)(Kp_ + (size_t)(lrow + 32) * kst_ + lkc * 8); \
            gv0 = *(const u32x4*)(Vp_ + (size_t)lrow * vst_ + lkc * 8); \
            gv1 = *(const u32x4*)(Vp_ + (size_t)(lrow + 32) * vst_ + lkc * 8); }
#define ATT_SWRITE(BUF) { \
            *(u32x4*)(Ks + ((BUF) * 64 + lrow) * KS_LD + lkc * 8) = gk0; \
            *(u32x4*)(Ks + ((BUF) * 64 + lrow + 32) * KS_LD + lkc * 8) = gk1; \
            u32x2* vd0_ = (u32x2*)(Vs + ((BUF) * 64 + lrow) * VS_LD + lkc * 8); \
            vd0_[0] = gv0.xy; vd0_[1] = gv0.zw; \
            u32x2* vd1_ = (u32x2*)(Vs + ((BUF) * 64 + lrow + 32) * VS_LD + lkc * 8); \
            vd1_[0] = gv1.xy; vd1_[1] = gv1.zw; }
        ATT_GLOAD(0);
        ATT_SWRITE(0);
        __syncthreads();
        for (int j = 0; j + 1 < ntiles; j++) {
            const int buf = j & 1;
            ATT_GLOAD(j + 1);
            __builtin_amdgcn_sched_barrier(0);
            {
                const bf16_t* kb = Ks + (buf * 64 + r) * KS_LD + hh * 8;
                const bf16_t* vb = Vs + (buf * 64 + r) * VS_LD + 4 * hh;
                const bool dmk = masked && j < nt0;
                const int kbase = kpos0 + j * 64 + 4 * hh - qpos;
                ATT_TILE(kb, KS_LD, vb, VS_LD, dmk, kbase);
            }
            __builtin_amdgcn_sched_barrier(0);
            ATT_SWRITE(buf ^ 1);
            __syncthreads();
        }
        {
            const int buf = (ntiles - 1) & 1;
            const bf16_t* kb = Ks + (buf * 64 + r) * KS_LD + hh * 8;
            const bf16_t* vb = Vs + (buf * 64 + r) * VS_LD + 4 * hh;
            ATT_TILE(kb, KS_LD, vb, VS_LD, false, 0);
        }
        __syncthreads();
        ATT_STORE(tq0 + w * 32 + r, gcol, mixer * 512 + head * 64);
    }
}

#define N_PHASES 15
#ifndef REP_MASK
#define REP_MASK 0
#endif
__device__ __forceinline__ void run_phase(const Params& p, int ph, char* smem, int rep) {
    const int slot = ph * 2 + rep;
    if (ph == 0) { phase_p0a(p, smem); return; }
    if (ph == 1) { phase_p0b(p, smem, slot); return; }
    if (ph == 14) { phase_norm(p, 4); return; }
    const int l = (ph - 2) / 3, s = (ph - 2) % 3;
    if (s == 0) { if (l & 1) phase_g1_odd(p, l >> 1, smem, slot); else phase_g1_even(p, l >> 1, smem, slot); }
    else if (s == 1) { if (l & 1) phase_f2(p, l >> 1, smem, slot); else phase_attn(p, l >> 1, smem, slot); }
    else phase_g2(p, l, smem, slot);
}
__device__ __forceinline__ bool probe_repeat(int ph) {
    if (REP_MASK == 0) return false;
    if (ph == 0) return (REP_MASK & 1) != 0;
    if (ph == 1) return (REP_MASK & 2) != 0;
    if (ph == 14) return false;
    const int l = (ph - 2) / 3, s = (ph - 2) % 3;
    if (s == 0) return (l & 1) ? (REP_MASK & 8) != 0 : ((REP_MASK & 4) != 0 && l > 0);
    if (s == 1) return (l & 1) ? (REP_MASK & 32) != 0 : (REP_MASK & 16) != 0;
    return false;
}

__global__ void __launch_bounds__(256, 2) mega_kernel(Params p, int ph_lo, int ph_hi) {
    __shared__ __attribute__((aligned(16))) char smem[SMEM_BYTES + 32];
#if MEGA
    volatile LAS unsigned* st = (volatile LAS unsigned*)(smem + SMEM_BYTES + 16);
    if (threadIdx.x == 0) { st[0] = 0u; st[1] = 0u; }
    __syncthreads();
    XcdBarrier xb = xcd_barrier_post(p.bar, st);
#endif
    for (int ph = ph_lo; ph < ph_hi; ph++) {
        run_phase(p, ph, smem, 0);
#if MEGA
        if (REP_MASK != 0 && probe_repeat(ph)) { xcd_barrier(xb); run_phase(p, ph, smem, 1); }
        if (ph + 1 < ph_hi) xcd_barrier(xb);
#endif
    }
}

extern "C" void kernel_launch(void* const* d_in, const int* in_sizes, int n_in, void* d_out, int out_size, void* d_ws, size_t ws_size,
                              hipStream_t stream) {
    Params p{};
    p.x_prompt = (const float*)d_in[0]; p.x_sample = (const float*)d_in[1];
    p.cache_k_a = (const float*)d_in[2]; p.cache_v_a = (const float*)d_in[3];
    p.cache_k_b = (const float*)d_in[4]; p.cache_v_b = (const float*)d_in[5];
    p.c = (const float*)d_in[6]; p.c_ctx = (const float*)d_in[7]; p.norm_g = (const float*)d_in[8];
    p.ada_w = (const float*)d_in[9]; p.ada_b = (const float*)d_in[10];
    p.even_w_in = (const float*)d_in[11]; p.even_w_out = (const float*)d_in[12];
    p.qk_g_q = (const float*)d_in[13]; p.qk_g_k = (const float*)d_in[14]; p.sink = (const float*)d_in[15];
    p.odd_w_in = (const float*)d_in[16]; p.odd_w_out = (const float*)d_in[17]; p.final_g = (const float*)d_in[18];
    p.out = (float*)d_out;
    char* ws = (char*)d_ws;
    size_t off = 0;
    auto take = [&](size_t bytes) { char* q = ws + off; off += (bytes + 255) & ~(size_t)255; return q; };
    p.bar = (unsigned*)take(XCD_BAR_WORDS * 4);
    p.ctr = (int*)take(36 * CTR_SLOT_WORDS * 4);
    const size_t zero_bytes = off;
    p.mod = (float*)take(4 * 3 * 3072 * 4);
    p.part = (float*)take((size_t)8 * NTOK * 4);
    p.shiftW = (float*)take(4 * 3 * 3072 * 4);
    p.rope = (float2*)take(1024 * 32 * 8);
    p.h = (bf16_t*)take((size_t)NTOK * LDK * 2);
    p.R = (bf16_t*)take((size_t)2048 * LDU * 2 + (size_t)NTOK * 1024 * 2);
    p.mix = (bf16_t*)take((size_t)NTOK * LDK * 2);
    p.winT_e = (bf16_t*)take((size_t)2 * 2560 * LDK * 2);
    p.woutT_e = (bf16_t*)take((size_t)2 * 1024 * LDK * 2);
    p.woutT_o = (bf16_t*)take((size_t)2 * 1024 * LDK * 2);
    p.wfT = (bf16_t*)take((size_t)2 * WF_ROWS * LDK * 2);
    p.wu = (bf16_t*)take((size_t)2 * 1024 * LDK * 2);
    p.D1024 = (bf16_t*)take((size_t)1024 * LDD1 * 2);
    p.D256 = (bf16_t*)take((size_t)256 * LDD2 * 2);
    p.Cc = (bf16_t*)take(256 * LDC * 2);
    p.Sc = (bf16_t*)take(256 * LDC * 2);
    p.vT_ctx = (bf16_t*)take((size_t)32 * 2 * 2 * 64 * 256 * 2);
    p.vT_lat = (bf16_t*)take((size_t)2 * 2 * 2 * 64 * 1024 * 2);
    p.cK = (bf16_t*)take((size_t)16 * 256 * 64 * 2);
    p.cVT = (bf16_t*)take((size_t)16 * 256 * 64 * 2);

    hipMemsetAsync(ws, 0, zero_bytes, stream);

    static int grid_blocks = 0;
    if (!grid_blocks) {
        int dev = 0, cus = 0, per_cu = 0;
        hipGetDevice(&dev);
        hipDeviceGetAttribute(&cus, hipDeviceAttributeMultiprocessorCount, dev);
        hipOccupancyMaxActiveBlocksPerMultiprocessor(&per_cu, mega_kernel, 256, 0);
        if (per_cu > 2) per_cu = 2;
        if (per_cu < 1) per_cu = 1;
        grid_blocks = cus * per_cu;
    }
#if MEGA
    int lo = 0, hi = N_PHASES;
    void* args[] = {&p, &lo, &hi};
    hipError_t e = hipLaunchCooperativeKernel((void*)mega_kernel, dim3(grid_blocks), dim3(256), args, 0, stream);
    if (e != hipSuccess) fprintf(stderr, "cooperative launch failed: %s (grid %d)\n", hipGetErrorString(e), grid_blocks);
#else
    for (int ph = 0; ph < N_PHASES; ph++) mega_kernel<<<grid_blocks, 256, 0, stream>>>(p, ph, ph + 1);
#endif
}
```

```cpp
#include <hip/hip_runtime.h>
#include <hip/hip_cooperative_groups.h>
#include <stdint.h>
#include <cstdio>

#ifndef MEGA
#define MEGA 1
#endif

typedef unsigned short bf16_t;
using bf16x8 = __attribute__((ext_vector_type(8))) __bf16;
using f32x16 = __attribute__((ext_vector_type(16))) float;
typedef __bf16 bf16x2_t __attribute__((ext_vector_type(2)));
using u32x4 = __attribute__((ext_vector_type(4))) unsigned;
using u32x2 = __attribute__((ext_vector_type(2))) unsigned;

#define NTOK 10240
#define NCTX 8192
#define DM 1024
#define SMEM_BYTES 73728
#define LDK 1088
#define LDU 10304
#define LDD1 2112
#define LDD2 576
#define LDC 320
#define WF_ROWS 2048

struct Params {
    const float *x_prompt, *x_sample, *cache_k_a, *cache_v_a, *cache_k_b, *cache_v_b, *c, *c_ctx, *norm_g, *ada_w, *ada_b,
        *even_w_in, *even_w_out, *qk_g_q, *qk_g_k, *sink, *odd_w_in, *odd_w_out, *final_g;
    float* out;
    unsigned* bar;
    int* ctr;
    float* part;
    float* shiftW;
    float* mod;
    float2* rope;
    bf16_t *h, *R, *mix, *winT_e, *woutT_e, *woutT_o, *wfT, *wu, *D1024, *D256, *Cc, *Sc, *vT_ctx, *vT_lat, *cK, *cVT;
};

__device__ __forceinline__ unsigned pack2(float a, float b) {
    bf16x2_t v = {(__bf16)a, (__bf16)b};
    return *(unsigned*)&v;
}
__device__ __forceinline__ bf16_t f2bf(float a) {
    __bf16 v = (__bf16)a;
    return *(bf16_t*)&v;
}
__device__ __forceinline__ float bf_lo(unsigned u) { return __uint_as_float(u << 16); }
__device__ __forceinline__ float bf_hi(unsigned u) { return __uint_as_float(u & 0xffff0000u); }
using f32x4n = __attribute__((ext_vector_type(4))) float;
__device__ __forceinline__ float4 ld_nt4(const float* p) { const f32x4n v = __builtin_nontemporal_load((const f32x4n*)p); return make_float4(v[0], v[1], v[2], v[3]); }
__device__ __forceinline__ float silu_f(float x) { return x / (1.0f + __expf(-x)); }
__device__ __forceinline__ int tid_l() { int t = threadIdx.x; asm volatile("" : "+v"(t)); return t; }

#define CTR_STRIDE 64
#define CTR_SLOT_WORDS 512
__device__ __forceinline__ unsigned xcc_id_hw() { return (unsigned)__builtin_amdgcn_s_getreg((3 << 11) | 20) & 0xFu; }
__device__ __forceinline__ int tq_next(int* ctr, int per_q, int myx, int& q, volatile int* s_slot, int tid, int per_q_odd = -1) {
    if (tid == 0) {
        int res = -1;
        while (q < 8) {
            const int qq = (myx + q) & 7;
            const int lim = (per_q_odd >= 0 && (qq & 1)) ? per_q_odd : per_q;
            const int idx = atomicAdd(&ctr[qq * CTR_STRIDE], 1);
            if (idx < lim) { res = (qq << 16) | idx; break; }
            q++;
        }
        *s_slot = res;
    }
    __syncthreads();
    const int r = __builtin_amdgcn_readfirstlane(*s_slot);
    __syncthreads();
    return r;
}

#define XB_TMO      128
#define XB_XCNT(j)  (256  + 64 * (j))
#define XB_XSUB(j)  (1280 + 64 * (j))
#define XB_XGEN(j)  (2304 + 64 * (j))
#define XB_TOP      3328
#define XB_TOPGEN   3392
#define XCD_BAR_WORDS 3456
#define XB_SPIN_CAP (1u << 20)
#define LAS __attribute__((address_space(3)))

__device__ __forceinline__ unsigned xb_ld(unsigned* p) { return __hip_atomic_load(p, __ATOMIC_RELAXED, __HIP_MEMORY_SCOPE_AGENT); }
__device__ __forceinline__ unsigned xb_add(unsigned* p, unsigned v) { return __hip_atomic_fetch_add(p, v, __ATOMIC_RELAXED, __HIP_MEMORY_SCOPE_AGENT); }
__device__ __forceinline__ unsigned xb_xcc_id() { return (unsigned)__builtin_amdgcn_s_getreg((3 << 11) | 20) & 0xFu; }
#define XB_SPIN(cond, bar) do { unsigned _sp = 0; while (cond) { __builtin_amdgcn_s_sleep(1); \
    if ((++_sp & 255u) == 0u) { if (xb_ld(&(bar)[XB_TMO])) break; if (_sp > XB_SPIN_CAP) { atomicAdd(&(bar)[XB_TMO], 1u); break; } } } } while (0)

struct XcdBarrier { unsigned* bar; unsigned x; volatile LAS unsigned* st; };

__device__ __forceinline__ XcdBarrier xcd_barrier_post(unsigned* bar, volatile LAS unsigned* st) {
    XcdBarrier b; b.bar = bar; b.x = xb_xcc_id(); b.st = st;
    if (threadIdx.x == 0) (void)xb_add(&bar[XB_XCNT(b.x)], 1u);
    return b;
}
__device__ __forceinline__ void xcd_barrier_complete(unsigned* bar, unsigned x, unsigned& nloc, unsigned& nx) {
    const unsigned G = gridDim.x * gridDim.y * gridDim.z;
    unsigned sum, cnt, mine, sp = 0u;
    for (;;) {
        sum = 0u; cnt = 0u; mine = 0u;
#pragma unroll
        for (unsigned j = 0; j < 16; ++j) { const unsigned c = xb_ld(&bar[XB_XCNT(j)]); sum += c; cnt += (c > 0u) ? 1u : 0u; mine = (j == x) ? c : mine; }
        if (sum == G) break;
        __builtin_amdgcn_s_sleep(1);
        if ((++sp & 255u) == 0u) { if (xb_ld(&bar[XB_TMO])) break; if (sp > XB_SPIN_CAP) { atomicAdd(&bar[XB_TMO], 1u); break; } }
    }
    nloc = mine > 0u ? mine : 1u; nx = cnt > 0u ? cnt : 1u;
}
__device__ __forceinline__ void xcd_barrier(const XcdBarrier& b) {
    asm volatile("s_waitcnt vmcnt(0)" ::: "memory");
    __syncthreads();
    if (threadIdx.x == 0) {
        unsigned* bar = b.bar;
        __builtin_amdgcn_s_waitcnt(0);
        unsigned nloc = b.st[0], nx = b.st[1];
        if (nloc == 0u) { xcd_barrier_complete(bar, b.x, nloc, nx); b.st[0] = nloc; b.st[1] = nx; }
        const unsigned old = xb_add(&bar[XB_XSUB(b.x)], 1u);
        const unsigned gen = old / nloc;
        if (old + 1u == (gen + 1u) * nloc) {
            __builtin_amdgcn_fence(__ATOMIC_RELEASE, "agent");
            asm volatile("s_waitcnt vmcnt(0)" ::: "memory");
            const unsigned og = xb_add(&bar[XB_TOP], 1u);
            const unsigned tg = og / nx;
            if (og + 1u == (tg + 1u) * nx) xb_add(&bar[XB_TOPGEN], 1u);
            else XB_SPIN(xb_ld(&bar[XB_TOPGEN]) == tg, bar);
            __builtin_amdgcn_fence(__ATOMIC_ACQUIRE, "agent");
            xb_add(&bar[XB_XGEN(b.x)], 1u);
            asm volatile("s_waitcnt vmcnt(0)" ::: "memory");
        } else {
            XB_SPIN(xb_ld(&bar[XB_XGEN(b.x)]) == gen, bar);
            __builtin_amdgcn_fence(__ATOMIC_ACQUIRE, "agent");
            asm volatile("s_waitcnt vmcnt(0)" ::: "memory");
        }
    }
    __syncthreads();
}

#define CS_LD 132
__device__ __forceinline__ void gemm_core(const bf16_t* __restrict__ A, int lda, const bf16_t* __restrict__ B0, const bf16_t* __restrict__ B1,
                                          int ksplit, int ldb, int K, char* smem) {
    bf16_t* As = (bf16_t*)smem;
    bf16_t* Bs = As + 2 * 128 * 72;
    const int tid = tid_l(), lane = tid & 63, w = tid >> 6;
    const int wm = w >> 1, wn = w & 1, r = lane & 31, hh = lane >> 5;
    const int lrow = tid >> 3, lkc = tid & 7;
    const unsigned voffA = (unsigned)(lrow * lda + lkc * 8) * 2u, voffB = (unsigned)(lrow * ldb + lkc * 8) * 2u;
    const __amdgpu_buffer_rsrc_t rsA = __builtin_amdgcn_make_buffer_rsrc((void*)A, 0, 0x7fffffff, 0x00020000);
    u32x4 ra[4], rb[4], rc[4], rd[4];
    f32x16 acc[2][2];
#pragma unroll
    for (int a = 0; a < 2; a++)
#pragma unroll
        for (int b = 0; b < 2; b++)
#pragma unroll
            for (int e = 0; e < 16; e++) acc[a][b][e] = 0.f;

    const int nk = K >> 6;
#define GEMM_LOAD(RA_, RB_, T_) { \
        const int t_ = ((T_) < nk) ? (T_) : (nk - 1); \
        const int k0_ = t_ << 6; \
        const bf16_t* Bp_ = (k0_ < ksplit) ? (B0 + k0_) : (B1 + (k0_ - ksplit)); \
        const __amdgpu_buffer_rsrc_t rsB_ = __builtin_amdgcn_make_buffer_rsrc((void*)Bp_, 0, 0x7fffffff, 0x00020000); \
        _Pragma("unroll") \
        for (int i = 0; i < 4; i++) { \
            RA_[i] = __builtin_amdgcn_raw_buffer_load_b128(rsA, voffA, ((32 * i) * lda + k0_) * 2, 0); \
            RB_[i] = __builtin_amdgcn_raw_buffer_load_b128(rsB_, voffB, ((32 * i) * ldb) * 2, 0); \
        } }
#define GEMM_WRITE(RA_, RB_, BUF_) { \
        _Pragma("unroll") \
        for (int i = 0; i < 4; i++) { \
            *(u32x4*)(As + (BUF_) * 128 * 72 + (lrow + 32 * i) * 72 + lkc * 8) = RA_[i]; \
            *(u32x4*)(Bs + (BUF_) * 128 * 72 + (lrow + 32 * i) * 72 + lkc * 8) = RB_[i]; \
        } }
    GEMM_LOAD(ra, rb, 0);
    GEMM_WRITE(ra, rb, 0);
    GEMM_LOAD(rc, rd, 1);
    GEMM_LOAD(ra, rb, 2);
    __syncthreads();
#define GEMM_COMPUTE(BUF) { \
        const bf16_t* as_ = As + (BUF) * 128 * 72 + (wm * 64 + r) * 72 + hh * 8; \
        const bf16_t* bs_ = Bs + (BUF) * 128 * 72 + (wn * 64 + r) * 72 + hh * 8; \
        _Pragma("unroll") \
        for (int ks = 0; ks < 4; ks++) { \
            bf16x8 a0 = *(const bf16x8*)(as_ + ks * 16); \
            bf16x8 a1 = *(const bf16x8*)(as_ + 32 * 72 + ks * 16); \
            bf16x8 b0 = *(const bf16x8*)(bs_ + ks * 16); \
            bf16x8 b1 = *(const bf16x8*)(bs_ + 32 * 72 + ks * 16); \
            acc[0][0] = __builtin_amdgcn_mfma_f32_32x32x16_bf16(a0, b0, acc[0][0], 0, 0, 0); \
            acc[0][1] = __builtin_amdgcn_mfma_f32_32x32x16_bf16(a0, b1, acc[0][1], 0, 0, 0); \
            acc[1][0] = __builtin_amdgcn_mfma_f32_32x32x16_bf16(a1, b0, acc[1][0], 0, 0, 0); \
            acc[1][1] = __builtin_amdgcn_mfma_f32_32x32x16_bf16(a1, b1, acc[1][1], 0, 0, 0); \
        } }
#define GEMM_COMPUTE_LD(BUF_, RA_, RB_, T_, WB_, PK_, LD_) { \
        const int t_ = ((T_) < nk) ? (T_) : (nk - 1); \
        const int k0_ = t_ << 6; \
        const bf16_t* Bp_ = (k0_ < ksplit) ? (B0 + k0_) : (B1 + (k0_ - ksplit)); \
        const __amdgpu_buffer_rsrc_t rsB_ = __builtin_amdgcn_make_buffer_rsrc((void*)Bp_, 0, 0x7fffffff, 0x00020000); \
        const bf16_t* as_ = As + (BUF_) * 128 * 72 + (wm * 64 + r) * 72 + hh * 8; \
        const bf16_t* bs_ = Bs + (BUF_) * 128 * 72 + (wn * 64 + r) * 72 + hh * 8; \
        bf16x8 a0 = *(const bf16x8*)(as_), a1 = *(const bf16x8*)(as_ + 32 * 72), b0 = *(const bf16x8*)(bs_), b1 = *(const bf16x8*)(bs_ + 32 * 72); \
        bf16x8 a0n = a0, a1n = a1, b0n = b0, b1n = b1; \
        _Pragma("unroll") \
        for (int ks = 0; ks < 4; ks++) { \
            if (ks < 3) {   \
                a0n = *(const bf16x8*)(as_ + (ks + 1) * 16); a1n = *(const bf16x8*)(as_ + 32 * 72 + (ks + 1) * 16); \
                b0n = *(const bf16x8*)(bs_ + (ks + 1) * 16); b1n = *(const bf16x8*)(bs_ + 32 * 72 + (ks + 1) * 16); \
            } \
            if (PK_) *(u32x4*)(As + (WB_) * 128 * 72 + (lrow + 32 * ks) * 72 + lkc * 8) = RA_[ks];        \
            if (LD_) RA_[ks] = __builtin_amdgcn_raw_buffer_load_b128(rsA, voffA, ((32 * ks) * lda + k0_) * 2, 0);                      \
            acc[0][0] = __builtin_amdgcn_mfma_f32_32x32x16_bf16(a0, b0, acc[0][0], 0, 0, 0); \
            acc[0][1] = __builtin_amdgcn_mfma_f32_32x32x16_bf16(a0, b1, acc[0][1], 0, 0, 0); \
            __builtin_amdgcn_sched_barrier(0); \
            if (PK_) *(u32x4*)(Bs + (WB_) * 128 * 72 + (lrow + 32 * ks) * 72 + lkc * 8) = RB_[ks]; \
            if (LD_) RB_[ks] = __builtin_amdgcn_raw_buffer_load_b128(rsB_, voffB, ((32 * ks) * ldb) * 2, 0); \
            acc[1][0] = __builtin_amdgcn_mfma_f32_32x32x16_bf16(a1, b0, acc[1][0], 0, 0, 0); \
            acc[1][1] = __builtin_amdgcn_mfma_f32_32x32x16_bf16(a1, b1, acc[1][1], 0, 0, 0); \
            __builtin_amdgcn_sched_barrier(0); \
            a0 = a0n; a1 = a1n; b0 = b0n; b1 = b1n; \
        } }
    for (int kt = 0; kt + 2 < nk; kt += 2) {
        GEMM_COMPUTE_LD(0, rc, rd, kt + 3, 1, true, true);
        __syncthreads();
        GEMM_COMPUTE_LD(1, ra, rb, kt + 4, 0, true, true);
        __syncthreads();
    }
    GEMM_COMPUTE_LD(0, rc, rd, nk - 1, 1, true, false);
    __syncthreads();
    GEMM_COMPUTE_LD(1, ra, rb, nk - 1, 0, false, false);
    __syncthreads();
    float* Cs = (float*)smem;
#pragma unroll
    for (int mi = 0; mi < 2; mi++)
#pragma unroll
        for (int ni = 0; ni < 2; ni++)
#pragma unroll
            for (int e = 0; e < 16; e++) {
                const int row = wm * 64 + mi * 32 + (e & 3) + 8 * (e >> 2) + 4 * hh;
                const int col = wn * 64 + ni * 32 + r;
                Cs[row * CS_LD + col] = acc[mi][ni][e];
            }
    __syncthreads();
}

__device__ __forceinline__ void cs_read_row(const float* Cs, int row, int half, float (&v)[64]) {
#pragma unroll
    for (int j = 0; j < 16; j++) {
        float4 f = *(const float4*)(Cs + row * CS_LD + half * 64 + j * 4);
        v[4 * j] = f.x; v[4 * j + 1] = f.y; v[4 * j + 2] = f.z; v[4 * j + 3] = f.w;
    }
}
__device__ __forceinline__ void store_row_bf16(bf16_t* dst, const float (&v)[64]) {
#pragma unroll
    for (int j = 0; j < 8; j++) {
        uint4 u;
        u.x = pack2(v[8 * j], v[8 * j + 1]); u.y = pack2(v[8 * j + 2], v[8 * j + 3]);
        u.z = pack2(v[8 * j + 4], v[8 * j + 5]); u.w = pack2(v[8 * j + 6], v[8 * j + 7]);
        *(uint4*)(dst + 8 * j) = u;
    }
}
__device__ __forceinline__ void store_row_f32(float* dst, const float (&v)[64]) {
#pragma unroll
    for (int j = 0; j < 16; j++) *(float4*)(dst + 4 * j) = make_float4(v[4 * j], v[4 * j + 1], v[4 * j + 2], v[4 * j + 3]);
}
__device__ __forceinline__ void cs_store_col(const float* Cs, int col, int rgrp, bf16_t* dst_col, const float* aff = nullptr) {
    const float sw = aff ? aff[128 + col] : 0.f;
#pragma unroll
    for (int ch = 0; ch < 8; ch++) {
        const int r0 = rgrp * 64 + ch * 8;
        float f[8];
#pragma unroll
        for (int e = 0; e < 8; e++) { f[e] = Cs[(r0 + e) * CS_LD + col]; if (aff) f[e] = f[e] * aff[r0 + e] + sw; }
        uint4 u;
        u.x = pack2(f[0], f[1]); u.y = pack2(f[2], f[3]); u.z = pack2(f[4], f[5]); u.w = pack2(f[6], f[7]);
        *(uint4*)(dst_col + r0) = u;
    }
}

#define AFF_OFF 67584
__device__ __forceinline__ float aff_prefetch(const Params& p, int l, int m0, int ncol0, int tid) {
    if (tid < 128) {
        const int t = m0 + tid;
        float ss = 0.f;
#pragma unroll
        for (int j = 0; j < 8; j++) ss += p.part[(size_t)j * NTOK + t];
        return rsqrtf(ss * (1.0f / 1024.0f) + 1e-6f);
    }
    const int mv = (m0 < NCTX) ? 0 : 1 + ((m0 - NCTX) >> 10);
    return p.shiftW[(size_t)(l * 3 + mv) * 3072 + ncol0 + (tid - 128)];
}
__device__ __forceinline__ void aff_publish(char* smem, float pre, int tid) {
    ((float*)(smem + AFF_OFF))[tid] = pre;
    __syncthreads();
}
__device__ __forceinline__ void aff_apply_row(const char* smem, int row, int half, float (&v)[64]) {
    const float* a = (const float*)(smem + AFF_OFF);
    const float rs = a[row];
#pragma unroll
    for (int j = 0; j < 16; j++) {
        const float4 s = *(const float4*)(a + 128 + half * 64 + 4 * j);
        v[4 * j] = v[4 * j] * rs + s.x; v[4 * j + 1] = v[4 * j + 1] * rs + s.y; v[4 * j + 2] = v[4 * j + 2] * rs + s.z; v[4 * j + 3] = v[4 * j + 3] * rs + s.w;
    }
}
__device__ void compute_shiftW(const Params& p) {
    const int tidn = tid_l(), lane = tidn & 63;
    const int gw = blockIdx.x * 4 + (tidn >> 6), nw = gridDim.x * 4;
    for (int task = gw; task < WF_ROWS + 2560 + WF_ROWS; task += nw) {
        int L, n; const bf16_t* Wr;
        if (task < WF_ROWS) { L = 1; n = task; Wr = p.wfT + (size_t)n * LDK; }
        else if (task < WF_ROWS + 2560) { L = 2; n = task - WF_ROWS; Wr = p.winT_e + (size_t)2560 * LDK + (size_t)n * LDK; }
        else { L = 3; n = task - WF_ROWS - 2560; Wr = p.wfT + (size_t)WF_ROWS * LDK + (size_t)n * LDK; }
        const u32x4 w0 = *(const u32x4*)(Wr + lane * 16), w1 = *(const u32x4*)(Wr + lane * 16 + 8);
        float wf[16];
        wf[0] = bf_lo(w0[0]); wf[1] = bf_hi(w0[0]); wf[2] = bf_lo(w0[1]); wf[3] = bf_hi(w0[1]);
        wf[4] = bf_lo(w0[2]); wf[5] = bf_hi(w0[2]); wf[6] = bf_lo(w0[3]); wf[7] = bf_hi(w0[3]);
        wf[8] = bf_lo(w1[0]); wf[9] = bf_hi(w1[0]); wf[10] = bf_lo(w1[1]); wf[11] = bf_hi(w1[1]);
        wf[12] = bf_lo(w1[2]); wf[13] = bf_hi(w1[2]); wf[14] = bf_lo(w1[3]); wf[15] = bf_hi(w1[3]);
        float acc[3];
#pragma unroll
        for (int mv = 0; mv < 3; mv++) {
            const float* sh = p.mod + (size_t)(L * 3 + mv) * 3072 + lane * 16;
            float a = 0.f;
#pragma unroll
            for (int j = 0; j < 4; j++) {
                const float4 s = *(const float4*)(sh + 4 * j);
                a += s.x * wf[4 * j] + s.y * wf[4 * j + 1] + s.z * wf[4 * j + 2] + s.w * wf[4 * j + 3];
            }
            acc[mv] = a;
        }
#pragma unroll
        for (int o = 32; o >= 1; o >>= 1) { acc[0] += __shfl_xor(acc[0], o); acc[1] += __shfl_xor(acc[1], o); acc[2] += __shfl_xor(acc[2], o); }
        if (lane == 0) {
            p.shiftW[(size_t)(L * 3 + 0) * 3072 + n] = acc[0];
            p.shiftW[(size_t)(L * 3 + 1) * 3072 + n] = acc[1];
            p.shiftW[(size_t)(L * 3 + 2) * 3072 + n] = acc[2];
        }
    }
}

__device__ void ada_item(const Params& p, int item, char* smem) {
    const int tid = tid_l();
    const int l = item / 96, cgp = item % 96, col0 = cgp * 32;
    float* sc = (float*)smem;
    float* red = sc + 3072;
    for (int i = tid; i < 3072; i += 256) {
        const int v = i >> 10, k = i & 1023;
        const float cv = (v == 0) ? p.c_ctx[k] : p.c[(v - 1) * 1024 + k];
        sc[i] = silu_f(cv);
    }
    __syncthreads();
    const int cl = tid & 7, slice = tid >> 3;
    float acc[12];
#pragma unroll
    for (int e = 0; e < 12; e++) acc[e] = 0.f;
    const float* wp = p.ada_w + ((size_t)l * 1024 + slice * 32) * 3072 + col0 + cl * 4;
#pragma unroll 8
    for (int kk = 0; kk < 32; kk++) {
        const float4 wv = ld_nt4(wp + (size_t)kk * 3072);
        const int k = slice * 32 + kk;
        const float s0 = sc[k], s1 = sc[1024 + k], s2 = sc[2048 + k];
        acc[0] += s0 * wv.x; acc[1] += s0 * wv.y; acc[2] += s0 * wv.z; acc[3] += s0 * wv.w;
        acc[4] += s1 * wv.x; acc[5] += s1 * wv.y; acc[6] += s1 * wv.z; acc[7] += s1 * wv.w;
        acc[8] += s2 * wv.x; acc[9] += s2 * wv.y; acc[10] += s2 * wv.z; acc[11] += s2 * wv.w;
    }
#pragma unroll
    for (int e = 0; e < 12; e++) red[tid * 12 + e] = acc[e];
    __syncthreads();
    if (tid < 96) {
        const int v = tid >> 5, cc = tid & 31, c4 = cc >> 2, e = cc & 3;
        float s = 0.f;
        for (int sl = 0; sl < 32; sl++) s += red[(sl * 8 + c4) * 12 + v * 4 + e];
        s += p.ada_b[l * 3072 + col0 + cc];
        p.mod[(l * 3 + v) * 3072 + col0 + cc] = s;
    }
    __syncthreads();
}

struct ConvDesc { const float* src; bf16_t* dst; int ld_src, ld_dst, r0, c0; bool transpose; };
__device__ __forceinline__ ConvDesc conv_decode(const Params& p, int j) {
    ConvDesc d;
    if (j < 640) {
        const int i = j / 320, tt = j % 320, kt2 = tt / 40, nt = tt % 40;
        d.src = p.even_w_in + (size_t)i * 1024 * 2560; d.ld_src = 2560; d.dst = p.winT_e + (size_t)i * 2560 * LDK; d.ld_dst = LDK; d.r0 = kt2 * 128; d.c0 = nt * 64; d.transpose = true;
        return d;
    }
    j -= 640;
    const int kind = j >> 8, jj = j & 255, i = jj >> 7, tt = jj & 127, kt2 = tt >> 4, nt = tt & 15;
    d.ld_dst = LDK; d.r0 = kt2 * 128; d.c0 = nt * 64; d.transpose = true;
    if (kind == 0) { d.src = p.even_w_out + (size_t)i * 1048576; d.ld_src = 1024; d.dst = p.woutT_e + (size_t)i * 1024 * LDK; }
    else if (kind == 1) { d.src = p.odd_w_out + (size_t)i * 1048576; d.ld_src = 1024; d.dst = p.woutT_o + (size_t)i * 1024 * LDK; }
    else if (kind == 2) { d.src = p.odd_w_in + (size_t)i * 1024 * 2048 + 1024; d.ld_src = 2048; d.dst = p.wfT + (size_t)i * WF_ROWS * LDK + (size_t)1024 * LDK; }
    else { d.src = p.odd_w_in + (size_t)i * 1024 * 2048; d.ld_src = 2048; d.dst = p.wu + (size_t)i * 1024 * LDK; d.transpose = false; }
    return d;
}
__device__ __forceinline__ void conv_load(const ConvDesc& d, int tid, float4 (&v)[8]) {
#pragma unroll
    for (int i = 0; i < 8; i++) {
        const int idx = tid + 256 * (i & 3), rr = (idx >> 4) + 64 * (i >> 2), c4 = idx & 15;
        v[i] = ld_nt4(d.src + (size_t)(d.r0 + rr) * d.ld_src + d.c0 + c4 * 4);
    }
}
__device__ __forceinline__ void conv_finish(const ConvDesc& d, int tid, const float4 (&v)[8], char* smem) {
    float* T = (float*)smem;
    if (!d.transpose) {
#pragma unroll
        for (int i = 0; i < 8; i++) {
            const int idx = tid + 256 * (i & 3), rr = (idx >> 4) + 64 * (i >> 2), c4 = idx & 15;
            uint2 u; u.x = pack2(v[i].x, v[i].y); u.y = pack2(v[i].z, v[i].w);
            *(uint2*)(d.dst + (size_t)(d.r0 + rr) * d.ld_dst + d.c0 + c4 * 4) = u;
        }
        return;
    }
#pragma unroll
    for (int hf = 0; hf < 2; hf++) {
#pragma unroll
        for (int i = 0; i < 4; i++) {
            const int idx = tid + 256 * i, rr = idx >> 4, c4 = idx & 15;
            T[rr * 65 + c4 * 4 + 0] = v[hf * 4 + i].x; T[rr * 65 + c4 * 4 + 1] = v[hf * 4 + i].y;
            T[rr * 65 + c4 * 4 + 2] = v[hf * 4 + i].z; T[rr * 65 + c4 * 4 + 3] = v[hf * 4 + i].w;
        }
        __syncthreads();
        {
            const int n = tid >> 2, kq = tid & 3;
            float f[16];
#pragma unroll
            for (int e = 0; e < 16; e++) f[e] = T[(kq * 16 + e) * 65 + n];
            uint4 u0, u1;
            u0.x = pack2(f[0], f[1]); u0.y = pack2(f[2], f[3]); u0.z = pack2(f[4], f[5]); u0.w = pack2(f[6], f[7]);
            u1.x = pack2(f[8], f[9]); u1.y = pack2(f[10], f[11]); u1.z = pack2(f[12], f[13]); u1.w = pack2(f[14], f[15]);
            bf16_t* dd = d.dst + (size_t)(d.c0 + n) * d.ld_dst + d.r0 + hf * 64 + kq * 16;
            *(uint4*)dd = u0; *(uint4*)(dd + 8) = u1;
        }
        __syncthreads();
    }
}

__device__ void phase_p0a(const Params& p, char* smem) {
    const int total = 384 + 640 + 4 * 256;
    {
        const int tid = tid_l();
        int item = blockIdx.x;
        if (item < 384) { ada_item(p, item, smem); item += gridDim.x; }
        float4 cur[8], nxt[8];
        if (item < total) { const ConvDesc d0 = conv_decode(p, item - 384); conv_load(d0, tid, cur); }
#pragma unroll 1
        while (item < total) {
            const int nitem = item + gridDim.x;
            if (nitem < total) { const ConvDesc dn = conv_decode(p, nitem - 384); conv_load(dn, tid, nxt); }
            const ConvDesc dc = conv_decode(p, item - 384);
            conv_finish(dc, tid, cur, smem);
#pragma unroll
            for (int i = 0; i < 8; i++) cur[i] = nxt[i];
            item = nitem;
        }
    }
    const int gt = blockIdx.x * 256 + tid_l(), gs = gridDim.x * 256;
    for (int e = gt; e < 65536; e += gs) {
        const int m = e >> 8, c = e & 255;
        const float x = 2.0f * (float)((m * c) & 255) * (1.0f / 256.0f);
        p.Cc[m * LDC + c] = f2bf(cospif(x) * 0.0625f);
        p.Sc[m * LDC + c] = f2bf((m == 0 ? ((c & 1) ? -1.0f : 1.0f) : sinpif(x)) * 0.0625f);
    }
    for (int e = gt; e < 256 * 512; e += gs) {
        const int k = e >> 9, kk = e & 511, s = kk & 255;
        const float x = 2.0f * (float)((k * s) & 255) * (1.0f / 256.0f);
        p.D256[k * LDD2 + kk] = f2bf((kk < 256 ? cospif(x) : -sinpif(x)) * 0.0625f);
    }
    for (int e = gt; e < 1024 * 2048 / 8; e += gs) {
        const int k = e >> 8, kk0 = (e & 255) * 8;
        float f[8];
#pragma unroll
        for (int j = 0; j < 8; j++) {
            const int kk = kk0 + j, s = kk & 1023;
            const float x = 2.0f * (float)((k * s) & 1023) * (1.0f / 1024.0f);
            f[j] = (kk < 1024 ? cospif(x) : -sinpif(x)) * 0.03125f;
        }
        u32x4 u;
        u[0] = pack2(f[0], f[1]); u[1] = pack2(f[2], f[3]); u[2] = pack2(f[4], f[5]); u[3] = pack2(f[6], f[7]);
        *(u32x4*)(p.D1024 + (size_t)k * LDD1 + kk0) = u;
    }
    for (int e = gt; e < 1024 * 32; e += gs) {
        const int pos = e >> 5, j = e & 31, f = j & 15;
        const float idx = (float)((j < 16) ? (pos >> 6) : (pos & 63));
        const float inv = 1.0f / powf(10000.0f, (float)f * (1.0f / 16.0f));
        const float ang = idx * inv;
        const float xpi = ang * 0.31830988618379067f;
        p.rope[e] = make_float2(cospif(xpi), sinpif(xpi));
    }
    for (int e = gt; e < 2 * 2 * 2 * 2 * 256 * 64; e += gs) {
        const int d = e & 63, pos = (e >> 6) & 255, kvh = (e >> 14) & 1, mixer = (e >> 15) & 1, bi = e >> 16;
        const float* ck = mixer ? p.cache_k_b : p.cache_k_a;
        const float* cv = mixer ? p.cache_v_b : p.cache_v_a;
        const size_t src = ((size_t)bi * 256 + pos) * 128 + kvh * 64 + d;
        p.cK[e] = f2bf(ck[src]);
        const int ci = (bi * 2 + mixer) * 2 + kvh;
        p.cVT[((size_t)ci * 64 + d) * 256 + pos] = f2bf(cv[src]);
    }
}

__device__ void phase_norm(const Params& p, int l  ) {
    const int tidn = tid_l();
    const int lane = tidn & 63;
    const int gw = blockIdx.x * 4 + (tidn >> 6), nw = gridDim.x * 4;
    for (int t0 = gw; t0 < NTOK; t0 += 2 * nw) {
        int tt[2]; tt[0] = t0; tt[1] = (t0 + nw < NTOK) ? t0 + nw : t0;
        float4 v[2][4];
        float ss[2];
#pragma unroll
        for (int u = 0; u < 2; u++) {
            const int t = tt[u];
            const float* src = (l == 0) ? (t < NCTX ? p.x_prompt + (size_t)t * DM : p.x_sample + (size_t)(t - NCTX) * DM) : p.out + (size_t)t * DM;
#pragma unroll
            for (int i = 0; i < 4; i++) v[u][i] = *(const float4*)(src + i * 256 + lane * 4);
        }
#pragma unroll
        for (int u = 0; u < 2; u++) {
            float s = 0.f;
#pragma unroll
            for (int i = 0; i < 4; i++) s += v[u][i].x * v[u][i].x + v[u][i].y * v[u][i].y + v[u][i].z * v[u][i].z + v[u][i].w * v[u][i].w;
#pragma unroll
            for (int o = 32; o >= 1; o >>= 1) s += __shfl_xor(s, o);
            ss[u] = s;
        }
#pragma unroll
        for (int u = 0; u < 2; u++) {
            const int t = tt[u];
            const float rstd = rsqrtf(ss[u] * (1.0f / 1024.0f) + 1e-6f);
            if (l < 4) {
                const int mv = (t < NCTX) ? 0 : 1 + ((t - NCTX) >> 10);
                const float* shift = p.mod + (size_t)(l * 3 + mv) * 3072;
                const float* scale = shift + 1024;
                const float* g = p.norm_g + l * 1024;
#pragma unroll
                for (int i = 0; i < 4; i++) {
                    const int col = i * 256 + lane * 4;
                    const float4 gg = *(const float4*)(g + col), sh = *(const float4*)(shift + col), sc = *(const float4*)(scale + col);
                    const float y0 = v[u][i].x * rstd * gg.x * (1.f + sc.x) + sh.x;
                    const float y1 = v[u][i].y * rstd * gg.y * (1.f + sc.y) + sh.y;
                    const float y2 = v[u][i].z * rstd * gg.z * (1.f + sc.z) + sh.z;
                    const float y3 = v[u][i].w * rstd * gg.w * (1.f + sc.w) + sh.w;
                    uint2 uu; uu.x = pack2(y0, y1); uu.y = pack2(y2, y3);
                    *(uint2*)(p.h + (size_t)t * LDK + col) = uu;
                }
            } else {
                const float* g = p.final_g;
#pragma unroll
                for (int i = 0; i < 4; i++) {
                    const int col = i * 256 + lane * 4;
                    const float4 gg = *(const float4*)(g + col);
                    *(float4*)(p.out + (size_t)t * DM + col) = make_float4(v[u][i].x * rstd * gg.x, v[u][i].y * rstd * gg.y, v[u][i].z * rstd * gg.z, v[u][i].w * rstd * gg.w);
                }
            }
        }
    }
}

__device__ void phase_p0b(const Params& p, char* smem, int slot) {
    const int tid = tid_l();
    int q_ = 0; const int myx = xcc_id_hw() & 7; int* ctr = p.ctr + slot * CTR_SLOT_WORDS;
    volatile int* s_item = (volatile int*)(smem + SMEM_BYTES);
    for (;;) {
        const int tk = tq_next(ctr, 16, myx, q_, s_item, tid);
        if (tk < 0) break;
        const int idx = (tk >> 16) * 16 + (tk & 0xffff);
        const int nt = idx & 7, g = (idx >> 3) & 3, trig = (idx >> 5) & 1, l = idx >> 6;
        const bf16_t* A = (trig ? p.Sc : p.Cc);
        const bf16_t* Bt = p.wu + (size_t)l * 1024 * LDK + (size_t)(nt * 128) * LDK + g * 256;
        gemm_core(A, LDC, Bt, Bt, 1 << 30, LDK, 256, smem);
        const float* Cs = (const float*)smem;
        const int row = tid >> 1, half = tid & 1;
        float v[64];
        cs_read_row(Cs, row, half, v);
        bf16_t* dst = p.wfT + (size_t)l * WF_ROWS * LDK + (size_t)(trig * 512 + g * 128 + row) * LDK + nt * 128 + half * 64;
        store_row_bf16(dst, v);
    }
    phase_norm(p, 0);
}

__device__ void phase_g1_even(const Params& p, int i, char* smem, int slot) {
    if (i == 0) compute_shiftW(p);
    const int tid = tid_l();
    const int NT = 20, total = 80 * NT;
    int q_ = 0; const int myx = xcc_id_hw() & 7; int* ctr = p.ctr + slot * CTR_SLOT_WORDS;
    volatile int* s_item = (volatile int*)(smem + SMEM_BYTES);
    for (;;) {
        const int tk = tq_next(ctr, total / 8, myx, q_, s_item, tid);
        if (tk < 0) break;
        const int xq = tk >> 16, idx = tk & 0xffff;
        const int mt = (xq >> 1) + 4 * (idx / (NT / 2)), nt = (xq & 1) * (NT / 2) + idx % (NT / 2), m0 = mt * 128;
        const bf16_t* A = p.h + (size_t)m0 * LDK;
        const bf16_t* Bt = p.winT_e + (size_t)i * 2560 * LDK + (size_t)(nt * 128) * LDK;
        float pre = 0.f;
        if (i > 0) pre = aff_prefetch(p, 2 * i, m0, nt * 128, tid);
        gemm_core(A, LDK, Bt, Bt, 1 << 30, LDK, 1024, smem);
        if (i > 0) aff_publish(smem, pre, tid);
        const float* aff = (i > 0) ? (const float*)(smem + AFF_OFF) : nullptr;
        const float* Cs = (const float*)smem;
        int seg;
        if (nt < 4) seg = 0; else if (nt == 4) seg = 1; else if (nt == 5) seg = 2; else if (nt < 10) seg = 3;
        else if (nt < 14) seg = 4; else if (nt == 14) seg = 5; else if (nt == 15) seg = 6; else seg = 7;
        const bool lat = m0 >= NCTX;
        const int row = tid >> 1, half = tid & 1;
        const int t = m0 + row;
        float v[64];
        cs_read_row(Cs, row, half, v);
        if (i > 0) aff_apply_row(smem, row, half, v);
        if (seg == 0 || seg == 1) {
            float ss = 0.f;
#pragma unroll
            for (int d = 0; d < 64; d++) ss += v[d] * v[d];
            const float rs = rsqrtf(ss * (1.0f / 64.0f) + 1e-6f);
            const float* g = (seg == 0 ? p.qk_g_q : p.qk_g_k) + i * 64;
#pragma unroll
            for (int d = 0; d < 64; d++) v[d] = v[d] * rs * g[d];
        }
        if (!lat && (seg == 1 || seg == 2 || seg == 5 || seg == 6)) {
            const int b = t >> 8, s = t & 255;
            const size_t off = (seg == 1 ? 10485760u : seg == 2 ? 12582912u : seg == 5 ? 14680064u : 16777216u);
            float* dst = p.out + off + ((size_t)(b * 2 + i) * 256 + s) * 128 + half * 64;
            store_row_f32(dst, v);
        }
        if (lat && (seg == 0 || seg == 1 || seg == 4 || seg == 5)) {
            const int pos = (t - NCTX) & 1023;
            const float2* rp = p.rope + pos * 32;
#pragma unroll
            for (int pp = 0; pp < 2; pp++)
#pragma unroll
                for (int f = 0; f < 16; f++) {
                    const float2 cs = rp[pp * 16 + f];
                    const float x1 = v[pp * 32 + f], x2 = v[pp * 32 + 16 + f];
                    v[pp * 32 + f] = x1 * cs.x - x2 * cs.y;
                    v[pp * 32 + 16 + f] = x2 * cs.x + x1 * cs.y;
                }
        }
        if (seg == 0 || seg == 4) {
#pragma unroll
            for (int d = 0; d < 64; d++) v[d] *= 0.18033688011112042f;
        }
        if (seg == 3 || seg == 7) {
#pragma unroll
            for (int d = 0; d < 64; d++) v[d] = silu_f(v[d]);
        }
        if (seg == 2 || seg == 6) {
            const int col = tid & 127, rgrp = tid >> 7, kvh = col >> 6, d = col & 63, mixer = (seg == 6);
            const int t0 = m0 + rgrp * 64;
            bf16_t* dst;
            if (!lat) { const int b = t0 >> 8, s = t0 & 255; dst = p.vT_ctx + ((size_t)(((b * 2 + mixer) * 2 + kvh) * 64 + d)) * 256 + s; }
            else { const int tl = t0 - NCTX, b = tl >> 10, s = tl & 1023; dst = p.vT_lat + ((size_t)(((b * 2 + mixer) * 2 + kvh) * 64 + d)) * 1024 + s; }
            cs_store_col(Cs, col, rgrp, dst - rgrp * 64, aff);
        } else {
            store_row_bf16(p.R + (size_t)t * 2560 + nt * 128 + half * 64, v);
        }
    }
}

__device__ __forceinline__ void cs_store_col2(const float* Cs, int col, int rgrp, bf16_t* dst1, bf16_t* dst2, unsigned flip, const float* aff) {
    const float sw = aff[128 + col];
#pragma unroll
    for (int ch = 0; ch < 8; ch++) {
        const int r0 = rgrp * 64 + ch * 8;
        float f[8];
#pragma unroll
        for (int e = 0; e < 8; e++) f[e] = Cs[(r0 + e) * CS_LD + col] * aff[r0 + e] + sw;
        u32x4 u;
        u[0] = pack2(f[0], f[1]); u[1] = pack2(f[2], f[3]); u[2] = pack2(f[4], f[5]); u[3] = pack2(f[6], f[7]);
        *(u32x4*)(dst1 + r0) = u;
        if (dst2) { u32x4 w = u; w[0] ^= flip; w[1] ^= flip; w[2] ^= flip; w[3] ^= flip; *(u32x4*)(dst2 + r0) = w; }
    }
}
__device__ void phase_g1_odd(const Params& p, int i, char* smem, int slot) {
    const int tid = tid_l();
    const int NT = 16, total = 80 * NT;
    bf16_t* UT = p.R;
    bf16_t* gbuf = p.R + (size_t)2048 * LDU;
    int q_ = 0; const int myx = xcc_id_hw() & 7; int* ctr = p.ctr + slot * CTR_SLOT_WORDS;
    volatile int* s_item = (volatile int*)(smem + SMEM_BYTES);
    for (;;) {
        const int tk = tq_next(ctr, 160, myx, q_, s_item, tid);
        if (tk < 0) break;
        const int xq = tk >> 16, idx = tk & 0xffff;
        const int mt = (xq >> 1) + 4 * (idx >> 3), nt = (xq & 1) * 8 + (idx & 7), m0 = mt * 128;
        const bf16_t* A = p.h + (size_t)m0 * LDK;
        const bf16_t* Bt = p.wfT + (size_t)i * WF_ROWS * LDK + (size_t)(nt * 128) * LDK;
        const float pre = aff_prefetch(p, 2 * i + 1, m0, nt * 128, tid);
        gemm_core(A, LDK, Bt, Bt, 1 << 30, LDK, 1024, smem);
        aff_publish(smem, pre, tid);
        const float* aff = (const float*)(smem + AFF_OFF);
        const float* Cs = (const float*)smem;
        if (nt < 8) {
            const int col = tid & 127, rgrp = tid >> 7, g = nt & 3, sinp = nt >> 2;
            bf16_t* base = UT + (size_t)(sinp * 1024 + g * 256) * LDU + m0;
            if (col >= 1) cs_store_col2(Cs, col, rgrp, base + (size_t)col * LDU, base + (size_t)(256 - col) * LDU, sinp ? 0x80008000u : 0u, aff);
            else if (!sinp) cs_store_col2(Cs, 0, rgrp, base, nullptr, 0u, aff);
            else {
                cs_store_col2(Cs, 0, rgrp, UT + (size_t)(g * 256 + 128) * LDU + m0, nullptr, 0u, aff);
                u32x4 zz; zz[0] = 0u; zz[1] = 0u; zz[2] = 0u; zz[3] = 0u;
                bf16_t* z0 = base + rgrp * 64;
                bf16_t* z1 = base + (size_t)128 * LDU + rgrp * 64;
#pragma unroll
                for (int ch = 0; ch < 8; ch++) { *(u32x4*)(z0 + ch * 8) = zz; *(u32x4*)(z1 + ch * 8) = zz; }
            }
        } else {
            const int row = tid >> 1, half = tid & 1;
            float v[64];
            cs_read_row(Cs, row, half, v);
            aff_apply_row(smem, row, half, v);
#pragma unroll
            for (int d = 0; d < 64; d++) v[d] = silu_f(v[d]);
            store_row_bf16(gbuf + (size_t)(m0 + row) * DM + (nt - 8) * 128 + half * 64, v);
        }
    }
}

__device__ void phase_f2(const Params& p, int i, char* smem, int slot) {
    const int tid = tid_l();
    bf16_t* UT = p.R;
    bf16_t* gbuf = p.R + (size_t)2048 * LDU;
    int q_ = 0; const int myx = xcc_id_hw() & 7; int* ctr = p.ctr + slot * CTR_SLOT_WORDS;
    volatile int* s_item = (volatile int*)(smem + SMEM_BYTES);
    for (;;) {
        const int tk = tq_next(ctr, 80, myx, q_, s_item, tid);
        if (tk < 0) break;
        const int xq = tk >> 16, idx = tk & 0xffff;
        int seq_base, S, mt, nt, ldd;
        const bf16_t* D;
        if (idx < 16) { const int b = xq >> 2; nt = (xq & 3) * 2 + (idx >> 3); mt = idx & 7; seq_base = NCTX + b * 1024; S = 1024; D = p.D1024; ldd = LDD1; }
        else { const int j = idx - 16; const int b = xq * 4 + (j >> 4); mt = (j >> 3) & 1; nt = j & 7; seq_base = b * 256; S = 256; D = p.D256; ldd = LDD2; }
        const bf16_t* A = D + (size_t)(mt * 128) * ldd;
        const bf16_t* B0 = UT + (size_t)(nt * 128) * LDU + seq_base;
        const bf16_t* B1 = UT + (size_t)(1024 + nt * 128) * LDU + seq_base;
        gemm_core(A, ldd, B0, B1, S, LDU, 2 * S, smem);
        const float* Cs = (const float*)smem;
        const int row = tid >> 1, half = tid & 1;
        const int tok = seq_base + mt * 128 + row;
        float v[64];
        cs_read_row(Cs, row, half, v);
        const bf16_t* gp = gbuf + (size_t)tok * DM + nt * 128 + half * 64;
#pragma unroll
        for (int j = 0; j < 8; j++) {
            const uint4 g = *(const uint4*)(gp + 8 * j);
            v[8 * j + 0] *= bf_lo(g.x); v[8 * j + 1] *= bf_hi(g.x);
            v[8 * j + 2] *= bf_lo(g.y); v[8 * j + 3] *= bf_hi(g.y);
            v[8 * j + 4] *= bf_lo(g.z); v[8 * j + 5] *= bf_hi(g.z);
            v[8 * j + 6] *= bf_lo(g.w); v[8 * j + 7] *= bf_hi(g.w);
        }
        store_row_bf16(p.mix + (size_t)tok * LDK + nt * 128 + half * 64, v);
    }
}

__device__ void phase_g2(const Params& p, int l, char* smem, int slot) {
    const int tid = tid_l();
    const int NT = 8, total = 80 * NT;
    const bf16_t* WT = ((l & 1) ? p.woutT_o : p.woutT_e) + (size_t)(l >> 1) * 1024 * LDK;
    int q_ = 0; const int myx = xcc_id_hw() & 7; int* ctr = p.ctr + slot * CTR_SLOT_WORDS;
    volatile int* s_item = (volatile int*)(smem + SMEM_BYTES);
    for (;;) {
        const int tk = tq_next(ctr, total / 8, myx, q_, s_item, tid);
        if (tk < 0) break;
        const int xq = tk >> 16, idx = tk & 0xffff;
        const int mt = xq + 8 * (idx >> 3), nt = idx & 7, m0 = mt * 128;
        const bf16_t* A = p.mix + (size_t)m0 * LDK;
        const bf16_t* Bt = WT + (size_t)(nt * 128) * LDK;
        gemm_core(A, LDK, Bt, Bt, 1 << 30, LDK, 1024, smem);
        const float* Cs = (const float*)smem;
        const int row = tid >> 1, half = tid & 1;
        const int t = m0 + row, c0 = nt * 128 + half * 64;
        float v[64];
        cs_read_row(Cs, row, half, v);
        const int mv = (t < NCTX) ? 0 : 1 + ((t - NCTX) >> 10);
        const float* gate = p.mod + (size_t)(l * 3 + mv) * 3072 + 2048 + c0;
        const float* xs = (l == 0) ? (t < NCTX ? p.x_prompt + (size_t)t * DM : p.x_sample + (size_t)(t - NCTX) * DM) : p.out + (size_t)t * DM;
        xs += c0;
        float* xo = p.out + (size_t)t * DM + c0;
#pragma unroll
        for (int c = 0; c < 2; c++) {
            float4 xv[8], gv[8];
#pragma unroll
            for (int j = 0; j < 8; j++) { xv[j] = *(const float4*)(xs + 32 * c + 4 * j); gv[j] = *(const float4*)(gate + 32 * c + 4 * j); }
#pragma unroll
            for (int j = 0; j < 8; j++) {
                const int o = 32 * c + 4 * j;
                v[o] = xv[j].x + gv[j].x * v[o]; v[o + 1] = xv[j].y + gv[j].y * v[o + 1];
                v[o + 2] = xv[j].z + gv[j].z * v[o + 2]; v[o + 3] = xv[j].w + gv[j].w * v[o + 3];
                *(float4*)(xo + o) = make_float4(v[o], v[o + 1], v[o + 2], v[o + 3]);
            }
        }
        if (l < 3) {
            float ss = 0.f;
#pragma unroll
            for (int d = 0; d < 64; d++) ss += v[d] * v[d];
            ss += __shfl_xor(ss, 1);
            if (half == 0) p.part[(size_t)nt * NTOK + t] = ss;
            const float* ng = p.norm_g + (l + 1) * 1024 + c0;
            const float* sc = p.mod + (size_t)((l + 1) * 3 + mv) * 3072 + 1024 + c0;
#pragma unroll
            for (int j = 0; j < 16; j++) {
                const float4 g4 = *(const float4*)(ng + 4 * j), s4 = *(const float4*)(sc + 4 * j);
                v[4 * j] *= g4.x * (1.f + s4.x); v[4 * j + 1] *= g4.y * (1.f + s4.y);
                v[4 * j + 2] *= g4.z * (1.f + s4.z); v[4 * j + 3] *= g4.w * (1.f + s4.w);
            }
            store_row_bf16(p.h + (size_t)t * LDK + c0, v);
        }
    }
}

#define KS_LD 72
#define VS_LD 68
#define VF_LD 260
#define ATT_TILE(KB_, KROWS_, VB_, VROWS_, DO_MASK_, KBASE_) { \
            f32x16 X[2]; \
            _Pragma("unroll") \
            for (int e = 0; e < 16; e++) { X[0][e] = 0.f; X[1][e] = 0.f; } \
            _Pragma("unroll") \
            for (int ks = 0; ks < 4; ks++) { \
                bf16x8 k0 = *(const bf16x8*)((KB_) + ks * 16); \
                bf16x8 k1 = *(const bf16x8*)((KB_) + 32 * (KROWS_) + ks * 16); \
                X[0] = __builtin_amdgcn_mfma_f32_32x32x16_bf16(k0, qf[ks], X[0], 0, 0, 0); \
                X[1] = __builtin_amdgcn_mfma_f32_32x32x16_bf16(k1, qf[ks], X[1], 0, 0, 0); \
            } \
            if (DO_MASK_) { \
                _Pragma("unroll") \
                for (int kt = 0; kt < 2; kt++) \
                    _Pragma("unroll") \
                    for (int e = 0; e < 16; e++) { \
                        const int rel = (KBASE_) + 32 * kt + (e & 3) + 8 * (e >> 2); \
                        if (rel > 128 || rel < -128) X[kt][e] = -1e30f; \
                    } \
            } \
            float mloc = fmaxf(X[0][0], X[1][0]); \
            _Pragma("unroll") \
            for (int e = 1; e < 16; e++) mloc = fmaxf(fmaxf(X[0][e], X[1][e]), mloc); \
            mloc = fmaxf(mloc, __shfl_xor(mloc, 32)); \
            const float m_new = fmaxf(m_run, mloc); \
            if (__builtin_amdgcn_ballot_w64(m_new != m_run) != 0ull) {        \
                const float alpha = __builtin_amdgcn_exp2f(m_run - m_new); \
                l_run *= alpha; \
                _Pragma("unroll") \
                for (int e = 0; e < 16; e++) { O[0][e] *= alpha; O[1][e] *= alpha; } \
                m_run = m_new; \
            } \
            float psum = 0.f; \
            _Pragma("unroll") \
            for (int kt = 0; kt < 2; kt++) \
                _Pragma("unroll") \
                for (int e = 0; e < 16; e++) { const float pv = __builtin_amdgcn_exp2f(X[kt][e] - m_new); X[kt][e] = pv; psum += pv; } \
            l_run += psum; \
            _Pragma("unroll") \
            for (int kt = 0; kt < 2; kt++) \
                _Pragma("unroll") \
                for (int s = 0; s < 2; s++) { \
                    u32x4 pbu; \
                    pbu[0] = pack2(X[kt][8 * s + 0], X[kt][8 * s + 1]); \
                    pbu[1] = pack2(X[kt][8 * s + 2], X[kt][8 * s + 3]); \
                    pbu[2] = pack2(X[kt][8 * s + 4], X[kt][8 * s + 5]); \
                    pbu[3] = pack2(X[kt][8 * s + 6], X[kt][8 * s + 7]); \
                    const bf16x8 pbv = (bf16x8)pbu; \
                    _Pragma("unroll") \
                    for (int dm = 0; dm < 2; dm++) { \
                        const bf16_t* vp = (VB_) + dm * 32 * (VROWS_) + 32 * kt + 16 * s; \
                        const u32x2 va0 = *(const u32x2*)(vp); \
                        const u32x2 va1 = *(const u32x2*)(vp + 8); \
                        u32x4 vau; \
                        vau[0] = va0[0]; vau[1] = va0[1]; vau[2] = va1[0]; vau[3] = va1[1]; \
                        O[dm] = __builtin_amdgcn_mfma_f32_32x32x16_bf16((bf16x8)vau, pbv, O[dm], 0, 0, 0); \
                    } \
                } \
        }
#define ATT_STORE(TQ_, GCOL_, MIXCOL_) { \
            const float l_tot = l_run + __shfl_xor(l_run, 32); \
            const float inv = 1.0f / l_tot; \
            const bf16_t* gp = p.R + (size_t)(TQ_) * 2560 + (GCOL_); \
            bf16_t* op = p.mix + (size_t)(TQ_) * LDK + (MIXCOL_); \
            _Pragma("unroll") \
            for (int dm = 0; dm < 2; dm++) \
                _Pragma("unroll") \
                for (int g4 = 0; g4 < 4; g4++) { \
                    const int d0 = dm * 32 + 8 * g4 + 4 * hh; \
                    const uint2 g = *(const uint2*)(gp + d0); \
                    const float o0 = O[dm][4 * g4 + 0] * inv * bf_lo(g.x); \
                    const float o1 = O[dm][4 * g4 + 1] * inv * bf_hi(g.x); \
                    const float o2 = O[dm][4 * g4 + 2] * inv * bf_lo(g.y); \
                    const float o3 = O[dm][4 * g4 + 3] * inv * bf_hi(g.y); \
                    uint2 u; u.x = pack2(o0, o1); u.y = pack2(o2, o3); \
                    *(uint2*)(op + d0) = u; \
                } \
        }

__device__ void phase_attn(const Params& p, int i, char* smem, int slot) {
    const int tid = tid_l(), lane = tid & 63, w = tid >> 6, r = lane & 31, hh = lane >> 5;
    bf16_t* Ks = (bf16_t*)smem;
    bf16_t* Vs = Ks + 2 * 64 * KS_LD;
    bf16_t* Vf = Ks + 256 * KS_LD;
    int q_ = 0; const int myx = xcc_id_hw() & 7; int* ctr = p.ctr + slot * CTR_SLOT_WORDS;
    volatile int* s_item = (volatile int*)(smem + SMEM_BYTES);
    for (;;) {
        const int tk = tq_next(ctr, 64, myx, q_, s_item, tid);
        if (tk < 0) break;
        const int xq = tk >> 16, idx = tk & 0xffff;
        if (idx >= 32) {
            const int j = idx - 32;
            const int b = xq * 4 + (j >> 3), mixer = (j >> 2) & 1, kvh = (j >> 1) & 1, pair = j & 1;
            const int kcol = (mixer ? 1792 : 512) + kvh * 64;
            const bf16_t* Kg = p.R + (size_t)(b * 256) * 2560 + kcol;
            const bf16_t* Vg = p.vT_ctx + (size_t)(((b * 2 + mixer) * 2 + kvh) * 64) * 256;
            {
                u32x4 kk[8], vv[8];
#pragma unroll
                for (int c = 0; c < 8; c++) {
                    const int ci = tid + 256 * c;
                    kk[c] = *(const u32x4*)(Kg + (size_t)(ci >> 3) * 2560 + (ci & 7) * 8);
                    vv[c] = *(const u32x4*)(Vg + (size_t)(ci >> 5) * 256 + (ci & 31) * 8);
                }
#pragma unroll
                for (int c = 0; c < 8; c++) {
                    const int ci = tid + 256 * c;
                    *(u32x4*)(Ks + (ci >> 3) * KS_LD + (ci & 7) * 8) = kk[c];
                    u32x2* vd = (u32x2*)(Vf + (ci >> 5) * VF_LD + (ci & 31) * 8);
                    vd[0] = vv[c].xy; vd[1] = vv[c].zw;
                }
            }
            __syncthreads();
#pragma unroll 1
            for (int sub = 0; sub < 4; sub++) {
                const int head = kvh * 4 + pair * 2 + (sub >> 1), qb = sub & 1;
                const int tq = b * 256 + qb * 128 + w * 32 + r;
                bf16x8 qf[4];
                {
                    const bf16_t* qp = p.R + (size_t)tq * 2560 + (mixer ? 1280 : 0) + head * 64 + hh * 8;
#pragma unroll
                    for (int ks = 0; ks < 4; ks++) qf[ks] = *(const bf16x8*)(qp + ks * 16);
                }
                float m_run, l_run;
                if (mixer) { m_run = p.sink[i * 8 + head] * 1.4426950408889634f; l_run = hh ? 0.f : 1.f; } else { m_run = -1e30f; l_run = 0.f; }
                f32x16 O[2];
#pragma unroll
                for (int e = 0; e < 16; e++) { O[0][e] = 0.f; O[1][e] = 0.f; }
#pragma unroll 1
                for (int jt = 0; jt < 4; jt++) {
                    const bf16_t* kb = Ks + (jt * 64 + r) * KS_LD + hh * 8;
                    const bf16_t* vb = Vf + r * VF_LD + jt * 64 + 4 * hh;
                    ATT_TILE(kb, KS_LD, vb, VF_LD, false, 0);
                }
                ATT_STORE(tq, (mixer ? 2048 : 768) + head * 64, mixer * 512 + head * 64);
            }
            __syncthreads();
            continue;
        }
        const int mixer = idx >> 4, b = xq >> 2, head = ((xq >> 1) & 1) * 4 + (xq & 1) * 2 + ((idx >> 3) & 1), qb = idx & 7;
        const int kvh = head >> 2;
        const int tq0 = NCTX + b * 1024 + qb * 128;
        const int qcol = (mixer ? 1280 : 0) + head * 64, kcol = (mixer ? 1792 : 512) + kvh * 64, gcol = (mixer ? 2048 : 768) + head * 64;
        int klo = 0, khi = 1024;
        if (mixer) { klo = (qb - 1) * 128; if (klo < 0) klo = 0; khi = (qb + 2) * 128; if (khi > 1024) khi = 1024; }
        const bf16_t* K0 = p.R + (size_t)(NCTX + b * 1024 + klo) * 2560 + kcol; const int ks0 = 2560;
        const bf16_t* V0 = p.vT_lat + (size_t)(((b * 2 + mixer) * 2 + kvh) * 64) * 1024 + klo; const int vs0 = 1024;
        const int nt0 = (khi - klo) >> 6, kpos0 = klo;
        const int ci = ((b * 2 + i) * 2 + mixer) * 2 + kvh;
        const bf16_t* K1 = p.cK + (size_t)ci * 256 * 64; const bf16_t* V1 = p.cVT + (size_t)ci * 64 * 256;
        const bool masked = mixer != 0;
        const int ntiles = nt0 + 4;
        bf16x8 qf[4];
        {
            const bf16_t* qp = p.R + (size_t)(tq0 + w * 32 + r) * 2560 + qcol + hh * 8;
#pragma unroll
            for (int ks = 0; ks < 4; ks++) qf[ks] = *(const bf16x8*)(qp + ks * 16);
        }
        float m_run, l_run;
        if (mixer) { m_run = p.sink[i * 8 + head] * 1.4426950408889634f; l_run = hh ? 0.f : 1.f; } else { m_run = -1e30f; l_run = 0.f; }
        f32x16 O[2];
#pragma unroll
        for (int e = 0; e < 16; e++) { O[0][e] = 0.f; O[1][e] = 0.f; }
        const int qpos = qb * 128 + w * 32 + r;

        u32x4 gk0, gk1, gv0, gv1;
        const int lrow = tid >> 3, lkc = tid & 7;
#define ATT_GLOAD(J) { \
            const bf16_t *Kp_, *Vp_; int kst_, vst_; \
            if ((J) < nt0) { Kp_ = K0 + (size_t)((J) * 64) * ks0; kst_ = ks0; Vp_ = V0 + (J) * 64; vst_ = vs0; } \
            else { Kp_ = K1 + (size_t)(((J) - nt0) * 64) * 64; kst_ = 64; Vp_ = V1 + ((J) - nt0) * 64; vst_ = 256; } \
            gk0 = *(const u32x4*)(Kp_ + (size_t)lrow * kst_ + lkc * 8); \
            gk1 = *(const u32x4*)(Kp_ + (size_t)(lrow + 32) * kst_ + lkc * 8); \
            gv0 = *(const u32x4*)(Vp_ + (size_t)lrow * vst_ + lkc * 8); \
            gv1 = *(const u32x4*)(Vp_ + (size_t)(lrow + 32) * vst_ + lkc * 8); }
#define ATT_SWRITE(BUF) { \
            *(u32x4*)(Ks + ((BUF) * 64 + lrow) * KS_LD + lkc * 8) = gk0; \
            *(u32x4*)(Ks + ((BUF) * 64 + lrow + 32) * KS_LD + lkc * 8) = gk1; \
            u32x2* vd0_ = (u32x2*)(Vs + ((BUF) * 64 + lrow) * VS_LD + lkc * 8); \
            vd0_[0] = gv0.xy; vd0_[1] = gv0.zw; \
            u32x2* vd1_ = (u32x2*)(Vs + ((BUF) * 64 + lrow + 32) * VS_LD + lkc * 8); \
            vd1_[0] = gv1.xy; vd1_[1] = gv1.zw; }
        ATT_GLOAD(0);
        ATT_SWRITE(0);
        __syncthreads();
        for (int j = 0; j + 1 < ntiles; j++) {
            const int buf = j & 1;
            ATT_GLOAD(j + 1);
            __builtin_amdgcn_sched_barrier(0);
            {
                const bf16_t* kb = Ks + (buf * 64 + r) * KS_LD + hh * 8;
                const bf16_t* vb = Vs + (buf * 64 + r) * VS_LD + 4 * hh;
                const bool dmk = masked && j < nt0;
                const int kbase = kpos0 + j * 64 + 4 * hh - qpos;
                ATT_TILE(kb, KS_LD, vb, VS_LD, dmk, kbase);
            }
            __builtin_amdgcn_sched_barrier(0);
            ATT_SWRITE(buf ^ 1);
            __syncthreads();
        }
        {
            const int buf = (ntiles - 1) & 1;
            const bf16_t* kb = Ks + (buf * 64 + r) * KS_LD + hh * 8;
            const bf16_t* vb = Vs + (buf * 64 + r) * VS_LD + 4 * hh;
            ATT_TILE(kb, KS_LD, vb, VS_LD, false, 0);
        }
        __syncthreads();
        ATT_STORE(tq0 + w * 32 + r, gcol, mixer * 512 + head * 64);
    }
}

#define N_PHASES 15
#ifndef REP_MASK
#define REP_MASK 0
#endif
__device__ __forceinline__ void run_phase(const Params& p, int ph, char* smem, int rep) {
    const int slot = ph * 2 + rep;
    if (ph == 0) { phase_p0a(p, smem); return; }
    if (ph == 1) { phase_p0b(p, smem, slot); return; }
    if (ph == 14) { phase_norm(p, 4); return; }
    const int l = (ph - 2) / 3, s = (ph - 2) % 3;
    if (s == 0) { if (l & 1) phase_g1_odd(p, l >> 1, smem, slot); else phase_g1_even(p, l >> 1, smem, slot); }
    else if (s == 1) { if (l & 1) phase_f2(p, l >> 1, smem, slot); else phase_attn(p, l >> 1, smem, slot); }
    else phase_g2(p, l, smem, slot);
}
__device__ __forceinline__ bool probe_repeat(int ph) {
    if (REP_MASK == 0) return false;
    if (ph == 0) return (REP_MASK & 1) != 0;
    if (ph == 1) return (REP_MASK & 2) != 0;
    if (ph == 14) return false;
    const int l = (ph - 2) / 3, s = (ph - 2) % 3;
    if (s == 0) return (l & 1) ? (REP_MASK & 8) != 0 : ((REP_MASK & 4) != 0 && l > 0);
    if (s == 1) return (l & 1) ? (REP_MASK & 32) != 0 : (REP_MASK & 16) != 0;
    return false;
}

__global__ void __launch_bounds__(256, 2) mega_kernel(Params p, int ph_lo, int ph_hi) {
    __shared__ __attribute__((aligned(16))) char smem[SMEM_BYTES + 32];
#if MEGA
    volatile LAS unsigned* st = (volatile LAS unsigned*)(smem + SMEM_BYTES + 16);
    if (threadIdx.x == 0) { st[0] = 0u; st[1] = 0u; }
    __syncthreads();
    XcdBarrier xb = xcd_barrier_post(p.bar, st);
#endif
    for (int ph = ph_lo; ph < ph_hi; ph++) {
        run_phase(p, ph, smem, 0);
#if MEGA
        if (REP_MASK != 0 && probe_repeat(ph)) { xcd_barrier(xb); run_phase(p, ph, smem, 1); }
        if (ph + 1 < ph_hi) xcd_barrier(xb);
#endif
    }
}

extern "C" void kernel_launch(void* const* d_in, const int* in_sizes, int n_in, void* d_out, int out_size, void* d_ws, size_t ws_size,
                              hipStream_t stream) {
    Params p{};
    p.x_prompt = (const float*)d_in[0]; p.x_sample = (const float*)d_in[1];
    p.cache_k_a = (const float*)d_in[2]; p.cache_v_a = (const float*)d_in[3];
    p.cache_k_b = (const float*)d_in[4]; p.cache_v_b = (const float*)d_in[5];
    p.c = (const float*)d_in[6]; p.c_ctx = (const float*)d_in[7]; p.norm_g = (const float*)d_in[8];
    p.ada_w = (const float*)d_in[9]; p.ada_b = (const float*)d_in[10];
    p.even_w_in = (const float*)d_in[11]; p.even_w_out = (const float*)d_in[12];
    p.qk_g_q = (const float*)d_in[13]; p.qk_g_k = (const float*)d_in[14]; p.sink = (const float*)d_in[15];
    p.odd_w_in = (const float*)d_in[16]; p.odd_w_out = (const float*)d_in[17]; p.final_g = (const float*)d_in[18];
    p.out = (float*)d_out;
    char* ws = (char*)d_ws;
    size_t off = 0;
    auto take = [&](size_t bytes) { char* q = ws + off; off += (bytes + 255) & ~(size_t)255; return q; };
    p.bar = (unsigned*)take(XCD_BAR_WORDS * 4);
    p.ctr = (int*)take(36 * CTR_SLOT_WORDS * 4);
    const size_t zero_bytes = off;
    p.mod = (float*)take(4 * 3 * 3072 * 4);
    p.part = (float*)take((size_t)8 * NTOK * 4);
    p.shiftW = (float*)take(4 * 3 * 3072 * 4);
    p.rope = (float2*)take(1024 * 32 * 8);
    p.h = (bf16_t*)take((size_t)NTOK * LDK * 2);
    p.R = (bf16_t*)take((size_t)2048 * LDU * 2 + (size_t)NTOK * 1024 * 2);
    p.mix = (bf16_t*)take((size_t)NTOK * LDK * 2);
    p.winT_e = (bf16_t*)take((size_t)2 * 2560 * LDK * 2);
    p.woutT_e = (bf16_t*)take((size_t)2 * 1024 * LDK * 2);
    p.woutT_o = (bf16_t*)take((size_t)2 * 1024 * LDK * 2);
    p.wfT = (bf16_t*)take((size_t)2 * WF_ROWS * LDK * 2);
    p.wu = (bf16_t*)take((size_t)2 * 1024 * LDK * 2);
    p.D1024 = (bf16_t*)take((size_t)1024 * LDD1 * 2);
    p.D256 = (bf16_t*)take((size_t)256 * LDD2 * 2);
    p.Cc = (bf16_t*)take(256 * LDC * 2);
    p.Sc = (bf16_t*)take(256 * LDC * 2);
    p.vT_ctx = (bf16_t*)take((size_t)32 * 2 * 2 * 64 * 256 * 2);
    p.vT_lat = (bf16_t*)take((size_t)2 * 2 * 2 * 64 * 1024 * 2);
    p.cK = (bf16_t*)take((size_t)16 * 256 * 64 * 2);
    p.cVT = (bf16_t*)take((size_t)16 * 256 * 64 * 2);

    hipMemsetAsync(ws, 0, zero_bytes, stream);

    static int grid_blocks = 0;
    if (!grid_blocks) {
        int dev = 0, cus = 0, per_cu = 0;
        hipGetDevice(&dev);
        hipDeviceGetAttribute(&cus, hipDeviceAttributeMultiprocessorCount, dev);
        hipOccupancyMaxActiveBlocksPerMultiprocessor(&per_cu, mega_kernel, 256, 0);
        if (per_cu > 2) per_cu = 2;
        if (per_cu < 1) per_cu = 1;
        grid_blocks = cus * per_cu;
    }
#if MEGA
    int lo = 0, hi = N_PHASES;
    void* args[] = {&p, &lo, &hi};
    hipError_t e = hipLaunchCooperativeKernel((void*)mega_kernel, dim3(grid_blocks), dim3(256), args, 0, stream);
    if (e != hipSuccess) fprintf(stderr, "cooperative launch failed: %s (grid %d)\n", hipGetErrorString(e), grid_blocks);
#else
    for (int ph = 0; ph < N_PHASES; ph++) mega_kernel<<<grid_blocks, 256, 0, stream>>>(p, ph, ph + 1);
#endif
}
```

```cpp
#include <hip/hip_runtime.h>
#include <hip/hip_cooperative_groups.h>
#include <stdint.h>
#include <cstdio>

#ifndef MEGA
#define MEGA 1
#endif

typedef unsigned short bf16_t;
using bf16x8 = __attribute__((ext_vector_type(8))) __bf16;
using f32x16 = __attribute__((ext_vector_type(16))) float;
typedef __bf16 bf16x2_t __attribute__((ext_vector_type(2)));
using u32x4 = __attribute__((ext_vector_type(4))) unsigned;
using u32x2 = __attribute__((ext_vector_type(2))) unsigned;

#define NTOK 10240
#define NCTX 8192
#define DM 1024
#define SMEM_BYTES 73728
#define LDK 1088
#define LDU 10304
#define LDD1 2112
#define LDD2 576
#define LDC 320
#define WF_ROWS 2048

struct Params {
    const float *x_prompt, *x_sample, *cache_k_a, *cache_v_a, *cache_k_b, *cache_v_b, *c, *c_ctx, *norm_g, *ada_w, *ada_b,
        *even_w_in, *even_w_out, *qk_g_q, *qk_g_k, *sink, *odd_w_in, *odd_w_out, *final_g;
    float* out;
    unsigned* bar;
    int* ctr;
    float* part;
    float* shiftW;
    float* mod;
    float2* rope;
    bf16_t *h, *R, *mix, *winT_e, *woutT_e, *woutT_o, *wfT, *wu, *D1024, *D256, *Cc, *Sc, *vT_ctx, *vT_lat, *cK, *cVT;
};

__device__ __forceinline__ unsigned pack2(float a, float b) {
    bf16x2_t v = {(__bf16)a, (__bf16)b};
    return *(unsigned*)&v;
}
__device__ __forceinline__ bf16_t f2bf(float a) {
    __bf16 v = (__bf16)a;
    return *(bf16_t*)&v;
}
__device__ __forceinline__ float bf_lo(unsigned u) { return __uint_as_float(u << 16); }
__device__ __forceinline__ float bf_hi(unsigned u) { return __uint_as_float(u & 0xffff0000u); }
using f32x4n = __attribute__((ext_vector_type(4))) float;
__device__ __forceinline__ float4 ld_nt4(const float* p) { const f32x4n v = __builtin_nontemporal_load((const f32x4n*)p); return make_float4(v[0], v[1], v[2], v[3]); }
__device__ __forceinline__ float silu_f(float x) { return x / (1.0f + __expf(-x)); }
__device__ __forceinline__ int tid_l() { int t = threadIdx.x; asm volatile("" : "+v"(t)); return t; }

#define CTR_STRIDE 64
#define CTR_SLOT_WORDS 512
__device__ __forceinline__ unsigned xcc_id_hw() { return (unsigned)__builtin_amdgcn_s_getreg((3 << 11) | 20) & 0xFu; }
__device__ __forceinline__ int tq_next(int* ctr, int per_q, int myx, int& q, volatile int* s_slot, int tid, int per_q_odd = -1) {
    if (tid == 0) {
        int res = -1;
        while (q < 8) {
            const int qq = (myx + q) & 7;
            const int lim = (per_q_odd >= 0 && (qq & 1)) ? per_q_odd : per_q;
            const int idx = atomicAdd(&ctr[qq * CTR_STRIDE], 1);
            if (idx < lim) { res = (qq << 16) | idx; break; }
            q++;
        }
        *s_slot = res;
    }
    __syncthreads();
    const int r = __builtin_amdgcn_readfirstlane(*s_slot);
    __syncthreads();
    return r;
}

#define XB_TMO      128
#define XB_XCNT(j)  (256  + 64 * (j))
#define XB_XSUB(j)  (1280 + 64 * (j))
#define XB_XGEN(j)  (2304 + 64 * (j))
#define XB_TOP      3328
#define XB_TOPGEN   3392
#define XCD_BAR_WORDS 3456
#define XB_SPIN_CAP (1u << 20)
#define LAS __attribute__((address_space(3)))

__device__ __forceinline__ unsigned xb_ld(unsigned* p) { return __hip_atomic_load(p, __ATOMIC_RELAXED, __HIP_MEMORY_SCOPE_AGENT); }
__device__ __forceinline__ unsigned xb_add(unsigned* p, unsigned v) { return __hip_atomic_fetch_add(p, v, __ATOMIC_RELAXED, __HIP_MEMORY_SCOPE_AGENT); }
__device__ __forceinline__ unsigned xb_xcc_id() { return (unsigned)__builtin_amdgcn_s_getreg((3 << 11) | 20) & 0xFu; }
#define XB_SPIN(cond, bar) do { unsigned _sp = 0; while (cond) { __builtin_amdgcn_s_sleep(1); \
    if ((++_sp & 255u) == 0u) { if (xb_ld(&(bar)[XB_TMO])) break; if (_sp > XB_SPIN_CAP) { atomicAdd(&(bar)[XB_TMO], 1u); break; } } } } while (0)

struct XcdBarrier { unsigned* bar; unsigned x; volatile LAS unsigned* st; };

__device__ __forceinline__ XcdBarrier xcd_barrier_post(unsigned* bar, volatile LAS unsigned* st) {
    XcdBarrier b; b.bar = bar; b.x = xb_xcc_id(); b.st = st;
    if (threadIdx.x == 0) (void)xb_add(&bar[XB_XCNT(b.x)], 1u);
    return b;
}
__device__ __forceinline__ void xcd_barrier_complete(unsigned* bar, unsigned x, unsigned& nloc, unsigned& nx) {
    const unsigned G = gridDim.x * gridDim.y * gridDim.z;
    unsigned sum, cnt, mine, sp = 0u;
    for (;;) {
        sum = 0u; cnt = 0u; mine = 0u;
#pragma unroll
        for (unsigned j = 0; j < 16; ++j) { const unsigned c = xb_ld(&bar[XB_XCNT(j)]); sum += c; cnt += (c > 0u) ? 1u : 0u; mine = (j == x) ? c : mine; }
        if (sum == G) break;
        __builtin_amdgcn_s_sleep(1);
        if ((++sp & 255u) == 0u) { if (xb_ld(&bar[XB_TMO])) break; if (sp > XB_SPIN_CAP) { atomicAdd(&bar[XB_TMO], 1u); break; } }
    }
    nloc = mine > 0u ? mine : 1u; nx = cnt > 0u ? cnt : 1u;
}
__device__ __forceinline__ void xcd_barrier(const XcdBarrier& b) {
    asm volatile("s_waitcnt vmcnt(0)" ::: "memory");
    __syncthreads();
    if (threadIdx.x == 0) {
        unsigned* bar = b.bar;
        __builtin_amdgcn_s_waitcnt(0);
        unsigned nloc = b.st[0], nx = b.st[1];
        if (nloc == 0u) { xcd_barrier_complete(bar, b.x, nloc, nx); b.st[0] = nloc; b.st[1] = nx; }
        const unsigned old = xb_add(&bar[XB_XSUB(b.x)], 1u);
        const unsigned gen = old / nloc;
        if (old + 1u == (gen + 1u) * nloc) {
            __builtin_amdgcn_fence(__ATOMIC_RELEASE, "agent");
            asm volatile("s_waitcnt vmcnt(0)" ::: "memory");
            const unsigned og = xb_add(&bar[XB_TOP], 1u);
            const unsigned tg = og / nx;
            if (og + 1u == (tg + 1u) * nx) xb_add(&bar[XB_TOPGEN], 1u);
            else XB_SPIN(xb_ld(&bar[XB_TOPGEN]) == tg, bar);
            __builtin_amdgcn_fence(__ATOMIC_ACQUIRE, "agent");
            xb_add(&bar[XB_XGEN(b.x)], 1u);
            asm volatile("s_waitcnt vmcnt(0)" ::: "memory");
        } else {
            XB_SPIN(xb_ld(&bar[XB_XGEN(b.x)]) == gen, bar);
            __builtin_amdgcn_fence(__ATOMIC_ACQUIRE, "agent");
            asm volatile("s_waitcnt vmcnt(0)" ::: "memory");
        }
    }
    __syncthreads();
}

#define CS_LD 132
__device__ __forceinline__ void gemm_core(const bf16_t* __restrict__ A, int lda, const bf16_t* __restrict__ B0, const bf16_t* __restrict__ B1,
                                          int ksplit, int ldb, int K, char* smem) {
    bf16_t* As = (bf16_t*)smem;
    bf16_t* Bs = As + 2 * 128 * 72;
    const int tid = tid_l(), lane = tid & 63, w = tid >> 6;
    const int wm = w >> 1, wn = w & 1, r = lane & 31, hh = lane >> 5;
    const int lrow = tid >> 3, lkc = tid & 7;
    const unsigned voffA = (unsigned)(lrow * lda + lkc * 8) * 2u, voffB = (unsigned)(lrow * ldb + lkc * 8) * 2u;
    const __amdgpu_buffer_rsrc_t rsA = __builtin_amdgcn_make_buffer_rsrc((void*)A, 0, 0x7fffffff, 0x00020000);
    u32x4 ra[4], rb[4], rc[4], rd[4];
    f32x16 acc[2][2];
#pragma unroll
    for (int a = 0; a < 2; a++)
#pragma unroll
        for (int b = 0; b < 2; b++)
#pragma unroll
            for (int e = 0; e < 16; e++) acc[a][b][e] = 0.f;

    const int nk = K >> 6;
#define GEMM_LOAD(RA_, RB_, T_) { \
        const int t_ = ((T_) < nk) ? (T_) : (nk - 1); \
        const int k0_ = t_ << 6; \
        const bf16_t* Bp_ = (k0_ < ksplit) ? (B0 + k0_) : (B1 + (k0_ - ksplit)); \
        const __amdgpu_buffer_rsrc_t rsB_ = __builtin_amdgcn_make_buffer_rsrc((void*)Bp_, 0, 0x7fffffff, 0x00020000); \
        _Pragma("unroll") \
        for (int i = 0; i < 4; i++) { \
            RA_[i] = __builtin_amdgcn_raw_buffer_load_b128(rsA, voffA, ((32 * i) * lda + k0_) * 2, 0); \
            RB_[i] = __builtin_amdgcn_raw_buffer_load_b128(rsB_, voffB, ((32 * i) * ldb) * 2, 0); \
        } }
#define GEMM_WRITE(RA_, RB_, BUF_) { \
        _Pragma("unroll") \
        for (int i = 0; i < 4; i++) { \
            *(u32x4*)(As + (BUF_) * 128 * 72 + (lrow + 32 * i) * 72 + lkc * 8) = RA_[i]; \
            *(u32x4*)(Bs + (BUF_) * 128 * 72 + (lrow + 32 * i) * 72 + lkc * 8) = RB_[i]; \
        } }
    GEMM_LOAD(ra, rb, 0);
    GEMM_WRITE(ra, rb, 0);
    GEMM_LOAD(rc, rd, 1);
    GEMM_LOAD(ra, rb, 2);
    __syncthreads();
#define GEMM_COMPUTE(BUF) { \
        const bf16_t* as_ = As + (BUF) * 128 * 72 + (wm * 64 + r) * 72 + hh * 8; \
        const bf16_t* bs_ = Bs + (BUF) * 128 * 72 + (wn * 64 + r) * 72 + hh * 8; \
        _Pragma("unroll") \
        for (int ks = 0; ks < 4; ks++) { \
            bf16x8 a0 = *(const bf16x8*)(as_ + ks * 16); \
            bf16x8 a1 = *(const bf16x8*)(as_ + 32 * 72 + ks * 16); \
            bf16x8 b0 = *(const bf16x8*)(bs_ + ks * 16); \
            bf16x8 b1 = *(const bf16x8*)(bs_ + 32 * 72 + ks * 16); \
            acc[0][0] = __builtin_amdgcn_mfma_f32_32x32x16_bf16(a0, b0, acc[0][0], 0, 0, 0); \
            acc[0][1] = __builtin_amdgcn_mfma_f32_32x32x16_bf16(a0, b1, acc[0][1], 0, 0, 0); \
            acc[1][0] = __builtin_amdgcn_mfma_f32_32x32x16_bf16(a1, b0, acc[1][0], 0, 0, 0); \
            acc[1][1] = __builtin_amdgcn_mfma_f32_32x32x16_bf16(a1, b1, acc[1][1], 0, 0, 0); \
        } }
#define GEMM_COMPUTE_LD(BUF_, RA_, RB_, T_, WB_, PK_, LD_) { \
        const int t_ = ((T_) < nk) ? (T_) : (nk - 1); \
        const int k0_ = t_ << 6; \
        const bf16_t* Bp_ = (k0_ < ksplit) ? (B0 + k0_) : (B1 + (k0_ - ksplit)); \
        const __amdgpu_buffer_rsrc_t rsB_ = __builtin_amdgcn_make_buffer_rsrc((void*)Bp_, 0, 0x7fffffff, 0x00020000); \
        const bf16_t* as_ = As + (BUF_) * 128 * 72 + (wm * 64 + r) * 72 + hh * 8; \
        const bf16_t* bs_ = Bs + (BUF_) * 128 * 72 + (wn * 64 + r) * 72 + hh * 8; \
        bf16x8 a0 = *(const bf16x8*)(as_), a1 = *(const bf16x8*)(as_ + 32 * 72), b0 = *(const bf16x8*)(bs_), b1 = *(const bf16x8*)(bs_ + 32 * 72); \
        bf16x8 a0n = a0, a1n = a1, b0n = b0, b1n = b1; \
        _Pragma("unroll") \
        for (int ks = 0; ks < 4; ks++) { \
            if (ks < 3) {   \
                a0n = *(const bf16x8*)(as_ + (ks + 1) * 16); a1n = *(const bf16x8*)(as_ + 32 * 72 + (ks + 1) * 16); \
                b0n = *(const bf16x8*)(bs_ + (ks + 1) * 16); b1n = *(const bf16x8*)(bs_ + 32 * 72 + (ks + 1) * 16); \
            } \
            if (PK_) *(u32x4*)(As + (WB_) * 128 * 72 + (lrow + 32 * ks) * 72 + lkc * 8) = RA_[ks];        \
            if (LD_) RA_[ks] = __builtin_amdgcn_raw_buffer_load_b128(rsA, voffA, ((32 * ks) * lda + k0_) * 2, 0);                      \
            acc[0][0] = __builtin_amdgcn_mfma_f32_32x32x16_bf16(a0, b0, acc[0][0], 0, 0, 0); \
            acc[0][1] = __builtin_amdgcn_mfma_f32_32x32x16_bf16(a0, b1, acc[0][1], 0, 0, 0); \
            __builtin_amdgcn_sched_barrier(0); \
            if (PK_) *(u32x4*)(Bs + (WB_) * 128 * 72 + (lrow + 32 * ks) * 72 + lkc * 8) = RB_[ks]; \
            if (LD_) RB_[ks] = __builtin_amdgcn_raw_buffer_load_b128(rsB_, voffB, ((32 * ks) * ldb) * 2, 0); \
            acc[1][0] = __builtin_amdgcn_mfma_f32_32x32x16_bf16(a1, b0, acc[1][0], 0, 0, 0); \
            acc[1][1] = __builtin_amdgcn_mfma_f32_32x32x16_bf16(a1, b1, acc[1][1], 0, 0, 0); \
            __builtin_amdgcn_sched_barrier(0); \
            a0 = a0n; a1 = a1n; b0 = b0n; b1 = b1n; \
        } }
    for (int kt = 0; kt + 2 < nk; kt += 2) {
        GEMM_COMPUTE_LD(0, rc, rd, kt + 3, 1, true, true);
        __syncthreads();
        GEMM_COMPUTE_LD(1, ra, rb, kt + 4, 0, true, true);
        __syncthreads();
    }
    GEMM_COMPUTE_LD(0, rc, rd, nk - 1, 1, true, false);
    __syncthreads();
    GEMM_COMPUTE_LD(1, ra, rb, nk - 1, 0, false, false);
    __syncthreads();
    float* Cs = (float*)smem;
#pragma unroll
    for (int mi = 0; mi < 2; mi++)
#pragma unroll
        for (int ni = 0; ni < 2; ni++)
#pragma unroll
            for (int e = 0; e < 16; e++) {
                const int row = wm * 64 + mi * 32 + (e & 3) + 8 * (e >> 2) + 4 * hh;
                const int col = wn * 64 + ni * 32 + r;
                Cs[row * CS_LD + col] = acc[mi][ni][e];
            }
    __syncthreads();
}

__device__ __forceinline__ void cs_read_row(const float* Cs, int row, int half, float (&v)[64]) {
#pragma unroll
    for (int j = 0; j < 16; j++) {
        float4 f = *(const float4*)(Cs + row * CS_LD + half * 64 + j * 4);
        v[4 * j] = f.x; v[4 * j + 1] = f.y; v[4 * j + 2] = f.z; v[4 * j + 3] = f.w;
    }
}
__device__ __forceinline__ void store_row_bf16(bf16_t* dst, const float (&v)[64]) {
#pragma unroll
    for (int j = 0; j < 8; j++) {
        uint4 u;
        u.x = pack2(v[8 * j], v[8 * j + 1]); u.y = pack2(v[8 * j + 2], v[8 * j + 3]);
        u.z = pack2(v[8 * j + 4], v[8 * j + 5]); u.w = pack2(v[8 * j + 6], v[8 * j + 7]);
        *(uint4*)(dst + 8 * j) = u;
    }
}
__device__ __forceinline__ void store_row_f32(float* dst, const float (&v)[64]) {
#pragma unroll
    for (int j = 0; j < 16; j++) *(float4*)(dst + 4 * j) = make_float4(v[4 * j], v[4 * j + 1], v[4 * j + 2], v[4 * j + 3]);
}
__device__ __forceinline__ void cs_store_col(const float* Cs, int col, int rgrp, bf16_t* dst_col, const float* aff = nullptr) {
    const float sw = aff ? aff[128 + col] : 0.f;
#pragma unroll
    for (int ch = 0; ch < 8; ch++) {
        const int r0 = rgrp * 64 + ch * 8;
        float f[8];
#pragma unroll
        for (int e = 0; e < 8; e++) { f[e] = Cs[(r0 + e) * CS_LD + col]; if (aff) f[e] = f[e] * aff[r0 + e] + sw; }
        uint4 u;
        u.x = pack2(f[0], f[1]); u.y = pack2(f[2], f[3]); u.z = pack2(f[4], f[5]); u.w = pack2(f[6], f[7]);
        *(uint4*)(dst_col + r0) = u;
    }
}

#define AFF_OFF 67584
__device__ __forceinline__ float aff_prefetch(const Params& p, int l, int m0, int ncol0, int tid) {
    if (tid < 128) {
        const int t = m0 + tid;
        float ss = 0.f;
#pragma unroll
        for (int j = 0; j < 8; j++) ss += p.part[(size_t)j * NTOK + t];
        return rsqrtf(ss * (1.0f / 1024.0f) + 1e-6f);
    }
    const int mv = (m0 < NCTX) ? 0 : 1 + ((m0 - NCTX) >> 10);
    return p.shiftW[(size_t)(l * 3 + mv) * 3072 + ncol0 + (tid - 128)];
}
__device__ __forceinline__ void aff_publish(char* smem, float pre, int tid) {
    ((float*)(smem + AFF_OFF))[tid] = pre;
    __syncthreads();
}
__device__ __forceinline__ void aff_apply_row(const char* smem, int row, int half, float (&v)[64]) {
    const float* a = (const float*)(smem + AFF_OFF);
    const float rs = a[row];
#pragma unroll
    for (int j = 0; j < 16; j++) {
        const float4 s = *(const float4*)(a + 128 + half * 64 + 4 * j);
        v[4 * j] = v[4 * j] * rs + s.x; v[4 * j + 1] = v[4 * j + 1] * rs + s.y; v[4 * j + 2] = v[4 * j + 2] * rs + s.z; v[4 * j + 3] = v[4 * j + 3] * rs + s.w;
    }
}
__device__ void compute_shiftW(const Params& p) {
    const int tidn = tid_l(), lane = tidn & 63;
    const int gw = blockIdx.x * 4 + (tidn >> 6), nw = gridDim.x * 4;
    const int total = WF_ROWS + 2560 + WF_ROWS;
    for (int task0 = gw; task0 < total; task0 += 2 * nw) {
        int Ls[2], ns[2]; const bf16_t* Wrs[2]; bool ok[2];
#pragma unroll
        for (int u = 0; u < 2; u++) {
            int task = task0 + u * nw; ok[u] = task < total; if (!ok[u]) task = task0;
            if (task < WF_ROWS) { Ls[u] = 1; ns[u] = task; Wrs[u] = p.wfT + (size_t)task * LDK; }
            else if (task < WF_ROWS + 2560) { Ls[u] = 2; ns[u] = task - WF_ROWS; Wrs[u] = p.winT_e + (size_t)2560 * LDK + (size_t)(task - WF_ROWS) * LDK; }
            else { Ls[u] = 3; ns[u] = task - WF_ROWS - 2560; Wrs[u] = p.wfT + (size_t)WF_ROWS * LDK + (size_t)(task - WF_ROWS - 2560) * LDK; }
        }
        u32x4 w0[2], w1[2];
#pragma unroll
        for (int u = 0; u < 2; u++) { w0[u] = *(const u32x4*)(Wrs[u] + lane * 16); w1[u] = *(const u32x4*)(Wrs[u] + lane * 16 + 8); }
        float acc[2][3];
#pragma unroll
        for (int u = 0; u < 2; u++) {
            float wf[16];
            wf[0] = bf_lo(w0[u][0]); wf[1] = bf_hi(w0[u][0]); wf[2] = bf_lo(w0[u][1]); wf[3] = bf_hi(w0[u][1]);
            wf[4] = bf_lo(w0[u][2]); wf[5] = bf_hi(w0[u][2]); wf[6] = bf_lo(w0[u][3]); wf[7] = bf_hi(w0[u][3]);
            wf[8] = bf_lo(w1[u][0]); wf[9] = bf_hi(w1[u][0]); wf[10] = bf_lo(w1[u][1]); wf[11] = bf_hi(w1[u][1]);
            wf[12] = bf_lo(w1[u][2]); wf[13] = bf_hi(w1[u][2]); wf[14] = bf_lo(w1[u][3]); wf[15] = bf_hi(w1[u][3]);
#pragma unroll
            for (int mv = 0; mv < 3; mv++) {
                const float* sh = p.mod + (size_t)(Ls[u] * 3 + mv) * 3072 + lane * 16;
                float a_ = 0.f;
#pragma unroll
                for (int j = 0; j < 4; j++) {
                    const float4 s = *(const float4*)(sh + 4 * j);
                    a_ += s.x * wf[4 * j] + s.y * wf[4 * j + 1] + s.z * wf[4 * j + 2] + s.w * wf[4 * j + 3];
                }
                acc[u][mv] = a_;
            }
        }
#pragma unroll
        for (int o = 32; o >= 1; o >>= 1)
#pragma unroll
            for (int u = 0; u < 2; u++) { acc[u][0] += __shfl_xor(acc[u][0], o); acc[u][1] += __shfl_xor(acc[u][1], o); acc[u][2] += __shfl_xor(acc[u][2], o); }
#pragma unroll
        for (int u = 0; u < 2; u++)
            if (lane == 0 && ok[u]) {
                p.shiftW[(size_t)(Ls[u] * 3 + 0) * 3072 + ns[u]] = acc[u][0];
                p.shiftW[(size_t)(Ls[u] * 3 + 1) * 3072 + ns[u]] = acc[u][1];
                p.shiftW[(size_t)(Ls[u] * 3 + 2) * 3072 + ns[u]] = acc[u][2];
            }
    }
}

__device__ void ada_item(const Params& p, int item, char* smem) {
    const int tid = tid_l();
    const int l = item / 96, cgp = item % 96, col0 = cgp * 32;
    float* sc = (float*)smem;
    float* red = sc + 3072;
    for (int i = tid; i < 3072; i += 256) {
        const int v = i >> 10, k = i & 1023;
        const float cv = (v == 0) ? p.c_ctx[k] : p.c[(v - 1) * 1024 + k];
        sc[i] = silu_f(cv);
    }
    __syncthreads();
    const int cl = tid & 7, slice = tid >> 3;
    float acc[12];
#pragma unroll
    for (int e = 0; e < 12; e++) acc[e] = 0.f;
    const float* wp = p.ada_w + ((size_t)l * 1024 + slice * 32) * 3072 + col0 + cl * 4;
#pragma unroll 8
    for (int kk = 0; kk < 32; kk++) {
        const float4 wv = ld_nt4(wp + (size_t)kk * 3072);
        const int k = slice * 32 + kk;
        const float s0 = sc[k], s1 = sc[1024 + k], s2 = sc[2048 + k];
        acc[0] += s0 * wv.x; acc[1] += s0 * wv.y; acc[2] += s0 * wv.z; acc[3] += s0 * wv.w;
        acc[4] += s1 * wv.x; acc[5] += s1 * wv.y; acc[6] += s1 * wv.z; acc[7] += s1 * wv.w;
        acc[8] += s2 * wv.x; acc[9] += s2 * wv.y; acc[10] += s2 * wv.z; acc[11] += s2 * wv.w;
    }
#pragma unroll
    for (int e = 0; e < 12; e++) red[tid * 12 + e] = acc[e];
    __syncthreads();
    if (tid < 96) {
        const int v = tid >> 5, cc = tid & 31, c4 = cc >> 2, e = cc & 3;
        float s = 0.f;
        for (int sl = 0; sl < 32; sl++) s += red[(sl * 8 + c4) * 12 + v * 4 + e];
        s += p.ada_b[l * 3072 + col0 + cc];
        p.mod[(l * 3 + v) * 3072 + col0 + cc] = s;
    }
    __syncthreads();
}

struct ConvDesc { const float* src; bf16_t* dst; int ld_src, ld_dst, r0, c0; bool transpose; };
__device__ __forceinline__ ConvDesc conv_decode(const Params& p, int j) {
    ConvDesc d;
    if (j < 640) {
        const int i = j / 320, tt = j % 320, kt2 = tt / 40, nt = tt % 40;
        d.src = p.even_w_in + (size_t)i * 1024 * 2560; d.ld_src = 2560; d.dst = p.winT_e + (size_t)i * 2560 * LDK; d.ld_dst = LDK; d.r0 = kt2 * 128; d.c0 = nt * 64; d.transpose = true;
        return d;
    }
    j -= 640;
    const int kind = j >> 8, jj = j & 255, i = jj >> 7, tt = jj & 127, kt2 = tt >> 4, nt = tt & 15;
    d.ld_dst = LDK; d.r0 = kt2 * 128; d.c0 = nt * 64; d.transpose = true;
    if (kind == 0) { d.src = p.even_w_out + (size_t)i * 1048576; d.ld_src = 1024; d.dst = p.woutT_e + (size_t)i * 1024 * LDK; }
    else if (kind == 1) { d.src = p.odd_w_out + (size_t)i * 1048576; d.ld_src = 1024; d.dst = p.woutT_o + (size_t)i * 1024 * LDK; }
    else if (kind == 2) { d.src = p.odd_w_in + (size_t)i * 1024 * 2048 + 1024; d.ld_src = 2048; d.dst = p.wfT + (size_t)i * WF_ROWS * LDK + (size_t)1024 * LDK; }
    else { d.src = p.odd_w_in + (size_t)i * 1024 * 2048; d.ld_src = 2048; d.dst = p.wu + (size_t)i * 1024 * LDK; d.transpose = false; }
    return d;
}
__device__ __forceinline__ void conv_load(const ConvDesc& d, int tid, float4 (&v)[8]) {
#pragma unroll
    for (int i = 0; i < 8; i++) {
        const int idx = tid + 256 * (i & 3), rr = (idx >> 4) + 64 * (i >> 2), c4 = idx & 15;
        v[i] = ld_nt4(d.src + (size_t)(d.r0 + rr) * d.ld_src + d.c0 + c4 * 4);
    }
}
__device__ __forceinline__ void conv_finish(const ConvDesc& d, int tid, const float4 (&v)[8], char* smem) {
    float* T = (float*)smem;
    if (!d.transpose) {
#pragma unroll
        for (int i = 0; i < 8; i++) {
            const int idx = tid + 256 * (i & 3), rr = (idx >> 4) + 64 * (i >> 2), c4 = idx & 15;
            uint2 u; u.x = pack2(v[i].x, v[i].y); u.y = pack2(v[i].z, v[i].w);
            *(uint2*)(d.dst + (size_t)(d.r0 + rr) * d.ld_dst + d.c0 + c4 * 4) = u;
        }
        return;
    }
#pragma unroll
    for (int hf = 0; hf < 2; hf++) {
#pragma unroll
        for (int i = 0; i < 4; i++) {
            const int idx = tid + 256 * i, rr = idx >> 4, c4 = idx & 15;
            T[rr * 65 + c4 * 4 + 0] = v[hf * 4 + i].x; T[rr * 65 + c4 * 4 + 1] = v[hf * 4 + i].y;
            T[rr * 65 + c4 * 4 + 2] = v[hf * 4 + i].z; T[rr * 65 + c4 * 4 + 3] = v[hf * 4 + i].w;
        }
        __syncthreads();
        {
            const int n = tid >> 2, kq = tid & 3;
            float f[16];
#pragma unroll
            for (int e = 0; e < 16; e++) f[e] = T[(kq * 16 + e) * 65 + n];
            uint4 u0, u1;
            u0.x = pack2(f[0], f[1]); u0.y = pack2(f[2], f[3]); u0.z = pack2(f[4], f[5]); u0.w = pack2(f[6], f[7]);
            u1.x = pack2(f[8], f[9]); u1.y = pack2(f[10], f[11]); u1.z = pack2(f[12], f[13]); u1.w = pack2(f[14], f[15]);
            bf16_t* dd = d.dst + (size_t)(d.c0 + n) * d.ld_dst + d.r0 + hf * 64 + kq * 16;
            *(uint4*)dd = u0; *(uint4*)(dd + 8) = u1;
        }
        __syncthreads();
    }
}

__device__ void phase_p0a(const Params& p, char* smem) {
    const int total = 384 + 640 + 4 * 256;
    {
        const int tid = tid_l();
        int item = blockIdx.x;
        if (item < 384) { ada_item(p, item, smem); item += gridDim.x; }
        float4 cur[8], nxt[8];
        if (item < total) { const ConvDesc d0 = conv_decode(p, item - 384); conv_load(d0, tid, cur); }
#pragma unroll 1
        while (item < total) {
            const int nitem = item + gridDim.x;
            if (nitem < total) { const ConvDesc dn = conv_decode(p, nitem - 384); conv_load(dn, tid, nxt); }
            const ConvDesc dc = conv_decode(p, item - 384);
            conv_finish(dc, tid, cur, smem);
#pragma unroll
            for (int i = 0; i < 8; i++) cur[i] = nxt[i];
            item = nitem;
        }
    }
    const int gt = blockIdx.x * 256 + tid_l(), gs = gridDim.x * 256;
    for (int e = gt; e < 65536; e += gs) {
        const int m = e >> 8, c = e & 255;
        const float x = 2.0f * (float)((m * c) & 255) * (1.0f / 256.0f);
        p.Cc[m * LDC + c] = f2bf(cospif(x) * 0.0625f);
        p.Sc[m * LDC + c] = f2bf((m == 0 ? ((c & 1) ? -1.0f : 1.0f) : sinpif(x)) * 0.0625f);
    }
    for (int e = gt; e < 256 * 512; e += gs) {
        const int k = e >> 9, kk = e & 511, s = kk & 255;
        const float x = 2.0f * (float)((k * s) & 255) * (1.0f / 256.0f);
        p.D256[k * LDD2 + kk] = f2bf((kk < 256 ? cospif(x) : -sinpif(x)) * 0.0625f);
    }
    for (int e = gt; e < 1024 * 2048 / 8; e += gs) {
        const int k = e >> 8, kk0 = (e & 255) * 8;
        float f[8];
#pragma unroll
        for (int j = 0; j < 8; j++) {
            const int kk = kk0 + j, s = kk & 1023;
            const float x = 2.0f * (float)((k * s) & 1023) * (1.0f / 1024.0f);
            f[j] = (kk < 1024 ? cospif(x) : -sinpif(x)) * 0.03125f;
        }
        u32x4 u;
        u[0] = pack2(f[0], f[1]); u[1] = pack2(f[2], f[3]); u[2] = pack2(f[4], f[5]); u[3] = pack2(f[6], f[7]);
        *(u32x4*)(p.D1024 + (size_t)k * LDD1 + kk0) = u;
    }
    for (int e = gt; e < 1024 * 32; e += gs) {
        const int pos = e >> 5, j = e & 31, f = j & 15;
        const float idx = (float)((j < 16) ? (pos >> 6) : (pos & 63));
        const float inv = 1.0f / powf(10000.0f, (float)f * (1.0f / 16.0f));
        const float ang = idx * inv;
        const float xpi = ang * 0.31830988618379067f;
        p.rope[e] = make_float2(cospif(xpi), sinpif(xpi));
    }
    for (int e = gt; e < 2 * 2 * 2 * 2 * 256 * 64; e += gs) {
        const int d = e & 63, pos = (e >> 6) & 255, kvh = (e >> 14) & 1, mixer = (e >> 15) & 1, bi = e >> 16;
        const float* ck = mixer ? p.cache_k_b : p.cache_k_a;
        const float* cv = mixer ? p.cache_v_b : p.cache_v_a;
        const size_t src = ((size_t)bi * 256 + pos) * 128 + kvh * 64 + d;
        p.cK[e] = f2bf(ck[src]);
        const int ci = (bi * 2 + mixer) * 2 + kvh;
        p.cVT[((size_t)ci * 64 + d) * 256 + pos] = f2bf(cv[src]);
    }
}

__device__ void phase_norm(const Params& p, int l  ) {
    const int tidn = tid_l();
    const int lane = tidn & 63;
    const int gw = blockIdx.x * 4 + (tidn >> 6), nw = gridDim.x * 4;
    for (int t0 = gw; t0 < NTOK; t0 += 2 * nw) {
        int tt[2]; tt[0] = t0; tt[1] = (t0 + nw < NTOK) ? t0 + nw : t0;
        float4 v[2][4];
        float ss[2];
#pragma unroll
        for (int u = 0; u < 2; u++) {
            const int t = tt[u];
            const float* src = (l == 0) ? (t < NCTX ? p.x_prompt + (size_t)t * DM : p.x_sample + (size_t)(t - NCTX) * DM) : p.out + (size_t)t * DM;
#pragma unroll
            for (int i = 0; i < 4; i++) v[u][i] = *(const float4*)(src + i * 256 + lane * 4);
        }
#pragma unroll
        for (int u = 0; u < 2; u++) {
            float s = 0.f;
#pragma unroll
            for (int i = 0; i < 4; i++) s += v[u][i].x * v[u][i].x + v[u][i].y * v[u][i].y + v[u][i].z * v[u][i].z + v[u][i].w * v[u][i].w;
#pragma unroll
            for (int o = 32; o >= 1; o >>= 1) s += __shfl_xor(s, o);
            ss[u] = s;
        }
#pragma unroll
        for (int u = 0; u < 2; u++) {
            const int t = tt[u];
            const float rstd = rsqrtf(ss[u] * (1.0f / 1024.0f) + 1e-6f);
            if (l < 4) {
                const int mv = (t < NCTX) ? 0 : 1 + ((t - NCTX) >> 10);
                const float* shift = p.mod + (size_t)(l * 3 + mv) * 3072;
                const float* scale = shift + 1024;
                const float* g = p.norm_g + l * 1024;
#pragma unroll
                for (int i = 0; i < 4; i++) {
                    const int col = i * 256 + lane * 4;
                    const float4 gg = *(const float4*)(g + col), sh = *(const float4*)(shift + col), sc = *(const float4*)(scale + col);
                    const float y0 = v[u][i].x * rstd * gg.x * (1.f + sc.x) + sh.x;
                    const float y1 = v[u][i].y * rstd * gg.y * (1.f + sc.y) + sh.y;
                    const float y2 = v[u][i].z * rstd * gg.z * (1.f + sc.z) + sh.z;
                    const float y3 = v[u][i].w * rstd * gg.w * (1.f + sc.w) + sh.w;
                    uint2 uu; uu.x = pack2(y0, y1); uu.y = pack2(y2, y3);
                    *(uint2*)(p.h + (size_t)t * LDK + col) = uu;
                }
            } else {
                const float* g = p.final_g;
#pragma unroll
                for (int i = 0; i < 4; i++) {
                    const int col = i * 256 + lane * 4;
                    const float4 gg = *(const float4*)(g + col);
                    *(float4*)(p.out + (size_t)t * DM + col) = make_float4(v[u][i].x * rstd * gg.x, v[u][i].y * rstd * gg.y, v[u][i].z * rstd * gg.z, v[u][i].w * rstd * gg.w);
                }
            }
        }
    }
}

__device__ void phase_p0b(const Params& p, char* smem, int slot) {
    const int tid = tid_l();
    int q_ = 0; const int myx = xcc_id_hw() & 7; int* ctr = p.ctr + slot * CTR_SLOT_WORDS;
    volatile int* s_item = (volatile int*)(smem + SMEM_BYTES);
    for (;;) {
        const int tk = tq_next(ctr, 16, myx, q_, s_item, tid);
        if (tk < 0) break;
        const int idx = (tk >> 16) * 16 + (tk & 0xffff);
        const int nt = idx & 7, g = (idx >> 3) & 3, trig = (idx >> 5) & 1, l = idx >> 6;
        const bf16_t* A = (trig ? p.Sc : p.Cc);
        const bf16_t* Bt = p.wu + (size_t)l * 1024 * LDK + (size_t)(nt * 128) * LDK + g * 256;
        gemm_core(A, LDC, Bt, Bt, 1 << 30, LDK, 256, smem);
        const float* Cs = (const float*)smem;
        const int row = tid >> 1, half = tid & 1;
        float v[64];
        cs_read_row(Cs, row, half, v);
        bf16_t* dst = p.wfT + (size_t)l * WF_ROWS * LDK + (size_t)(trig * 512 + g * 128 + row) * LDK + nt * 128 + half * 64;
        store_row_bf16(dst, v);
    }
    phase_norm(p, 0);
}

__device__ void phase_g1_even(const Params& p, int i, char* smem, int slot) {
    if (i == 0) compute_shiftW(p);
    const int tid = tid_l();
    const int NT = 20, total = 80 * NT;
    int q_ = 0; const int myx = xcc_id_hw() & 7; int* ctr = p.ctr + slot * CTR_SLOT_WORDS;
    volatile int* s_item = (volatile int*)(smem + SMEM_BYTES);
    for (;;) {
        const int tk = tq_next(ctr, total / 8, myx, q_, s_item, tid);
        if (tk < 0) break;
        const int xq = tk >> 16, idx = tk & 0xffff;
        const int mt = (xq >> 1) + 4 * (idx / (NT / 2)), nt = (xq & 1) * (NT / 2) + idx % (NT / 2), m0 = mt * 128;
        const bf16_t* A = p.h + (size_t)m0 * LDK;
        const bf16_t* Bt = p.winT_e + (size_t)i * 2560 * LDK + (size_t)(nt * 128) * LDK;
        float pre = 0.f;
        if (i > 0) pre = aff_prefetch(p, 2 * i, m0, nt * 128, tid);
        gemm_core(A, LDK, Bt, Bt, 1 << 30, LDK, 1024, smem);
        if (i > 0) aff_publish(smem, pre, tid);
        const float* aff = (i > 0) ? (const float*)(smem + AFF_OFF) : nullptr;
        const float* Cs = (const float*)smem;
        int seg;
        if (nt < 4) seg = 0; else if (nt == 4) seg = 1; else if (nt == 5) seg = 2; else if (nt < 10) seg = 3;
        else if (nt < 14) seg = 4; else if (nt == 14) seg = 5; else if (nt == 15) seg = 6; else seg = 7;
        const bool lat = m0 >= NCTX;
        const int row = tid >> 1, half = tid & 1;
        const int t = m0 + row;
        float v[64];
        cs_read_row(Cs, row, half, v);
        if (i > 0) aff_apply_row(smem, row, half, v);
        if (seg == 0 || seg == 1) {
            float ss = 0.f;
#pragma unroll
            for (int d = 0; d < 64; d++) ss += v[d] * v[d];
            const float rs = rsqrtf(ss * (1.0f / 64.0f) + 1e-6f);
            const float* g = (seg == 0 ? p.qk_g_q : p.qk_g_k) + i * 64;
#pragma unroll
            for (int d = 0; d < 64; d++) v[d] = v[d] * rs * g[d];
        }
        if (!lat && (seg == 1 || seg == 2 || seg == 5 || seg == 6)) {
            const int b = t >> 8, s = t & 255;
            const size_t off = (seg == 1 ? 10485760u : seg == 2 ? 12582912u : seg == 5 ? 14680064u : 16777216u);
            float* dst = p.out + off + ((size_t)(b * 2 + i) * 256 + s) * 128 + half * 64;
            store_row_f32(dst, v);
        }
        if (lat && (seg == 0 || seg == 1 || seg == 4 || seg == 5)) {
            const int pos = (t - NCTX) & 1023;
            const float2* rp = p.rope + pos * 32;
#pragma unroll
            for (int pp = 0; pp < 2; pp++)
#pragma unroll
                for (int f = 0; f < 16; f++) {
                    const float2 cs = rp[pp * 16 + f];
                    const float x1 = v[pp * 32 + f], x2 = v[pp * 32 + 16 + f];
                    v[pp * 32 + f] = x1 * cs.x - x2 * cs.y;
                    v[pp * 32 + 16 + f] = x2 * cs.x + x1 * cs.y;
                }
        }
        if (seg == 0 || seg == 4) {
#pragma unroll
            for (int d = 0; d < 64; d++) v[d] *= 0.18033688011112042f;
        }
        if (seg == 3 || seg == 7) {
#pragma unroll
            for (int d = 0; d < 64; d++) v[d] = silu_f(v[d]);
        }
        if (seg == 2 || seg == 6) {
            const int col = tid & 127, rgrp = tid >> 7, kvh = col >> 6, d = col & 63, mixer = (seg == 6);
            const int t0 = m0 + rgrp * 64;
            bf16_t* dst;
            if (!lat) { const int b = t0 >> 8, s = t0 & 255; dst = p.vT_ctx + ((size_t)(((b * 2 + mixer) * 2 + kvh) * 64 + d)) * 256 + s; }
            else { const int tl = t0 - NCTX, b = tl >> 10, s = tl & 1023; dst = p.vT_lat + ((size_t)(((b * 2 + mixer) * 2 + kvh) * 64 + d)) * 1024 + s; }
            cs_store_col(Cs, col, rgrp, dst - rgrp * 64, aff);
        } else {
            store_row_bf16(p.R + (size_t)t * 2560 + nt * 128 + half * 64, v);
        }
    }
}

__device__ __forceinline__ void cs_store_col2(const float* Cs, int col, int rgrp, bf16_t* dst1, bf16_t* dst2, unsigned flip, const float* aff) {
    const float sw = aff[128 + col];
#pragma unroll
    for (int ch = 0; ch < 8; ch++) {
        const int r0 = rgrp * 64 + ch * 8;
        float f[8];
#pragma unroll
        for (int e = 0; e < 8; e++) f[e] = Cs[(r0 + e) * CS_LD + col] * aff[r0 + e] + sw;
        u32x4 u;
        u[0] = pack2(f[0], f[1]); u[1] = pack2(f[2], f[3]); u[2] = pack2(f[4], f[5]); u[3] = pack2(f[6], f[7]);
        *(u32x4*)(dst1 + r0) = u;
        if (dst2) { u32x4 w = u; w[0] ^= flip; w[1] ^= flip; w[2] ^= flip; w[3] ^= flip; *(u32x4*)(dst2 + r0) = w; }
    }
}
__device__ void phase_g1_odd(const Params& p, int i, char* smem, int slot) {
    const int tid = tid_l();
    const int NT = 16, total = 80 * NT;
    bf16_t* UT = p.R;
    bf16_t* gbuf = p.R + (size_t)2048 * LDU;
    int q_ = 0; const int myx = xcc_id_hw() & 7; int* ctr = p.ctr + slot * CTR_SLOT_WORDS;
    volatile int* s_item = (volatile int*)(smem + SMEM_BYTES);
    for (;;) {
        const int tk = tq_next(ctr, 160, myx, q_, s_item, tid);
        if (tk < 0) break;
        const int xq = tk >> 16, idx = tk & 0xffff;
        const int mt = (xq >> 1) + 4 * (idx >> 3), nt = (xq & 1) * 8 + (idx & 7), m0 = mt * 128;
        const bf16_t* A = p.h + (size_t)m0 * LDK;
        const bf16_t* Bt = p.wfT + (size_t)i * WF_ROWS * LDK + (size_t)(nt * 128) * LDK;
        const float pre = aff_prefetch(p, 2 * i + 1, m0, nt * 128, tid);
        gemm_core(A, LDK, Bt, Bt, 1 << 30, LDK, 1024, smem);
        aff_publish(smem, pre, tid);
        const float* aff = (const float*)(smem + AFF_OFF);
        const float* Cs = (const float*)smem;
        if (nt < 8) {
            const int col = tid & 127, rgrp = tid >> 7, g = nt & 3, sinp = nt >> 2;
            bf16_t* base = UT + (size_t)(sinp * 1024 + g * 256) * LDU + m0;
            if (col >= 1) cs_store_col2(Cs, col, rgrp, base + (size_t)col * LDU, base + (size_t)(256 - col) * LDU, sinp ? 0x80008000u : 0u, aff);
            else if (!sinp) cs_store_col2(Cs, 0, rgrp, base, nullptr, 0u, aff);
            else {
                cs_store_col2(Cs, 0, rgrp, UT + (size_t)(g * 256 + 128) * LDU + m0, nullptr, 0u, aff);
                u32x4 zz; zz[0] = 0u; zz[1] = 0u; zz[2] = 0u; zz[3] = 0u;
                bf16_t* z0 = base + rgrp * 64;
                bf16_t* z1 = base + (size_t)128 * LDU + rgrp * 64;
#pragma unroll
                for (int ch = 0; ch < 8; ch++) { *(u32x4*)(z0 + ch * 8) = zz; *(u32x4*)(z1 + ch * 8) = zz; }
            }
        } else {
            const int row = tid >> 1, half = tid & 1;
            float v[64];
            cs_read_row(Cs, row, half, v);
            aff_apply_row(smem, row, half, v);
#pragma unroll
            for (int d = 0; d < 64; d++) v[d] = silu_f(v[d]);
            store_row_bf16(gbuf + (size_t)(m0 + row) * DM + (nt - 8) * 128 + half * 64, v);
        }
    }
}

__device__ void phase_f2(const Params& p, int i, char* smem, int slot) {
    const int tid = tid_l();
    bf16_t* UT = p.R;
    bf16_t* gbuf = p.R + (size_t)2048 * LDU;
    int q_ = 0; const int myx = xcc_id_hw() & 7; int* ctr = p.ctr + slot * CTR_SLOT_WORDS;
    volatile int* s_item = (volatile int*)(smem + SMEM_BYTES);
    for (;;) {
        const int tk = tq_next(ctr, 80, myx, q_, s_item, tid);
        if (tk < 0) break;
        const int xq = tk >> 16, idx = tk & 0xffff;
        int seq_base, S, mt, nt, ldd;
        const bf16_t* D;
        if (idx < 16) { const int b = xq >> 2; nt = (xq & 3) * 2 + (idx >> 3); mt = idx & 7; seq_base = NCTX + b * 1024; S = 1024; D = p.D1024; ldd = LDD1; }
        else { const int j = idx - 16; const int b = xq * 4 + (j >> 4); mt = (j >> 3) & 1; nt = j & 7; seq_base = b * 256; S = 256; D = p.D256; ldd = LDD2; }
        const bf16_t* A = D + (size_t)(mt * 128) * ldd;
        const bf16_t* B0 = UT + (size_t)(nt * 128) * LDU + seq_base;
        const bf16_t* B1 = UT + (size_t)(1024 + nt * 128) * LDU + seq_base;
        gemm_core(A, ldd, B0, B1, S, LDU, 2 * S, smem);
        const float* Cs = (const float*)smem;
        const int row = tid >> 1, half = tid & 1;
        const int tok = seq_base + mt * 128 + row;
        float v[64];
        cs_read_row(Cs, row, half, v);
        const bf16_t* gp = gbuf + (size_t)tok * DM + nt * 128 + half * 64;
#pragma unroll
        for (int j = 0; j < 8; j++) {
            const uint4 g = *(const uint4*)(gp + 8 * j);
            v[8 * j + 0] *= bf_lo(g.x); v[8 * j + 1] *= bf_hi(g.x);
            v[8 * j + 2] *= bf_lo(g.y); v[8 * j + 3] *= bf_hi(g.y);
            v[8 * j + 4] *= bf_lo(g.z); v[8 * j + 5] *= bf_hi(g.z);
            v[8 * j + 6] *= bf_lo(g.w); v[8 * j + 7] *= bf_hi(g.w);
        }
        store_row_bf16(p.mix + (size_t)tok * LDK + nt * 128 + half * 64, v);
    }
}

__device__ void phase_g2(const Params& p, int l, char* smem, int slot) {
    const int tid = tid_l();
    const int NT = 8, total = 80 * NT;
    const bf16_t* WT = ((l & 1) ? p.woutT_o : p.woutT_e) + (size_t)(l >> 1) * 1024 * LDK;
    int q_ = 0; const int myx = xcc_id_hw() & 7; int* ctr = p.ctr + slot * CTR_SLOT_WORDS;
    volatile int* s_item = (volatile int*)(smem + SMEM_BYTES);
    for (;;) {
        const int tk = tq_next(ctr, total / 8, myx, q_, s_item, tid);
        if (tk < 0) break;
        const int xq = tk >> 16, idx = tk & 0xffff;
        const int mt = xq + 8 * (idx >> 3), nt = idx & 7, m0 = mt * 128;
        const bf16_t* A = p.mix + (size_t)m0 * LDK;
        const bf16_t* Bt = WT + (size_t)(nt * 128) * LDK;
        gemm_core(A, LDK, Bt, Bt, 1 << 30, LDK, 1024, smem);
        const float* Cs = (const float*)smem;
        const int row = tid >> 1, half = tid & 1;
        const int t = m0 + row, c0 = nt * 128 + half * 64;
        float v[64];
        cs_read_row(Cs, row, half, v);
        const int mv = (t < NCTX) ? 0 : 1 + ((t - NCTX) >> 10);
        const float* gate = p.mod + (size_t)(l * 3 + mv) * 3072 + 2048 + c0;
        const float* xs = (l == 0) ? (t < NCTX ? p.x_prompt + (size_t)t * DM : p.x_sample + (size_t)(t - NCTX) * DM) : p.out + (size_t)t * DM;
        xs += c0;
        float* xo = p.out + (size_t)t * DM + c0;
#pragma unroll
        for (int c = 0; c < 2; c++) {
            float4 xv[8], gv[8];
#pragma unroll
            for (int j = 0; j < 8; j++) { xv[j] = *(const float4*)(xs + 32 * c + 4 * j); gv[j] = *(const float4*)(gate + 32 * c + 4 * j); }
#pragma unroll
            for (int j = 0; j < 8; j++) {
                const int o = 32 * c + 4 * j;
                v[o] = xv[j].x + gv[j].x * v[o]; v[o + 1] = xv[j].y + gv[j].y * v[o + 1];
                v[o + 2] = xv[j].z + gv[j].z * v[o + 2]; v[o + 3] = xv[j].w + gv[j].w * v[o + 3];
                *(float4*)(xo + o) = make_float4(v[o], v[o + 1], v[o + 2], v[o + 3]);
            }
        }
        if (l < 3) {
            float ss = 0.f;
#pragma unroll
            for (int d = 0; d < 64; d++) ss += v[d] * v[d];
            ss += __shfl_xor(ss, 1);
            if (half == 0) p.part[(size_t)nt * NTOK + t] = ss;
            const float* ng = p.norm_g + (l + 1) * 1024 + c0;
            const float* sc = p.mod + (size_t)((l + 1) * 3 + mv) * 3072 + 1024 + c0;
#pragma unroll
            for (int j = 0; j < 16; j++) {
                const float4 g4 = *(const float4*)(ng + 4 * j), s4 = *(const float4*)(sc + 4 * j);
                v[4 * j] *= g4.x * (1.f + s4.x); v[4 * j + 1] *= g4.y * (1.f + s4.y);
                v[4 * j + 2] *= g4.z * (1.f + s4.z); v[4 * j + 3] *= g4.w * (1.f + s4.w);
            }
            store_row_bf16(p.h + (size_t)t * LDK + c0, v);
        }
    }
}

#define KS_LD 72
#define VS_LD 68
#define VF_LD 260
#define ATT_TILE(KB_, KROWS_, VB_, VROWS_, DO_MASK_, KBASE_) { \
            f32x16 X[2]; \
            _Pragma("unroll") \
            for (int e = 0; e < 16; e++) { X[0][e] = 0.f; X[1][e] = 0.f; } \
            _Pragma("unroll") \
            for (int ks = 0; ks < 4; ks++) { \
                bf16x8 k0 = *(const bf16x8*)((KB_) + ks * 16); \
                bf16x8 k1 = *(const bf16x8*)((KB_) + 32 * (KROWS_) + ks * 16); \
                X[0] = __builtin_amdgcn_mfma_f32_32x32x16_bf16(k0, qf[ks], X[0], 0, 0, 0); \
                X[1] = __builtin_amdgcn_mfma_f32_32x32x16_bf16(k1, qf[ks], X[1], 0, 0, 0); \
            } \
            if (DO_MASK_) { \
                _Pragma("unroll") \
                for (int kt = 0; kt < 2; kt++) \
                    _Pragma("unroll") \
                    for (int e = 0; e < 16; e++) { \
                        const int rel = (KBASE_) + 32 * kt + (e & 3) + 8 * (e >> 2); \
                        if (rel > 128 || rel < -128) X[kt][e] = -1e30f; \
                    } \
            } \
            float mloc = fmaxf(X[0][0], X[1][0]); \
            _Pragma("unroll") \
            for (int e = 1; e < 16; e++) mloc = fmaxf(fmaxf(X[0][e], X[1][e]), mloc); \
            mloc = fmaxf(mloc, __shfl_xor(mloc, 32)); \
            const float m_new = fmaxf(m_run, mloc); \
            if (__builtin_amdgcn_ballot_w64(m_new != m_run) != 0ull) {        \
                const float alpha = __builtin_amdgcn_exp2f(m_run - m_new); \
                l_run *= alpha; \
                _Pragma("unroll") \
                for (int e = 0; e < 16; e++) { O[0][e] *= alpha; O[1][e] *= alpha; } \
                m_run = m_new; \
            } \
            float psum = 0.f; \
            _Pragma("unroll") \
            for (int kt = 0; kt < 2; kt++) \
                _Pragma("unroll") \
                for (int e = 0; e < 16; e++) { const float pv = __builtin_amdgcn_exp2f(X[kt][e] - m_new); X[kt][e] = pv; psum += pv; } \
            l_run += psum; \
            _Pragma("unroll") \
            for (int kt = 0; kt < 2; kt++) \
                _Pragma("unroll") \
                for (int s = 0; s < 2; s++) { \
                    u32x4 pbu; \
                    pbu[0] = pack2(X[kt][8 * s + 0], X[kt][8 * s + 1]); \
                    pbu[1] = pack2(X[kt][8 * s + 2], X[kt][8 * s + 3]); \
                    pbu[2] = pack2(X[kt][8 * s + 4], X[kt][8 * s + 5]); \
                    pbu[3] = pack2(X[kt][8 * s + 6], X[kt][8 * s + 7]); \
                    const bf16x8 pbv = (bf16x8)pbu; \
                    _Pragma("unroll") \
                    for (int dm = 0; dm < 2; dm++) { \
                        const bf16_t* vp = (VB_) + dm * 32 * (VROWS_) + 32 * kt + 16 * s; \
                        const u32x2 va0 = *(const u32x2*)(vp); \
                        const u32x2 va1 = *(const u32x2*)(vp + 8); \
                        u32x4 vau; \
                        vau[0] = va0[0]; vau[1] = va0[1]; vau[2] = va1[0]; vau[3] = va1[1]; \
                        O[dm] = __builtin_amdgcn_mfma_f32_32x32x16_bf16((bf16x8)vau, pbv, O[dm], 0, 0, 0); \
                    } \
                } \
        }
#define ATT_STORE(TQ_, GCOL_, MIXCOL_) { \
            const float l_tot = l_run + __shfl_xor(l_run, 32); \
            const float inv = 1.0f / l_tot; \
            const bf16_t* gp = p.R + (size_t)(TQ_) * 2560 + (GCOL_); \
            bf16_t* op = p.mix + (size_t)(TQ_) * LDK + (MIXCOL_); \
            _Pragma("unroll") \
            for (int dm = 0; dm < 2; dm++) \
                _Pragma("unroll") \
                for (int g4 = 0; g4 < 4; g4++) { \
                    const int d0 = dm * 32 + 8 * g4 + 4 * hh; \
                    const uint2 g = *(const uint2*)(gp + d0); \
                    const float o0 = O[dm][4 * g4 + 0] * inv * bf_lo(g.x); \
                    const float o1 = O[dm][4 * g4 + 1] * inv * bf_hi(g.x); \
                    const float o2 = O[dm][4 * g4 + 2] * inv * bf_lo(g.y); \
                    const float o3 = O[dm][4 * g4 + 3] * inv * bf_hi(g.y); \
                    uint2 u; u.x = pack2(o0, o1); u.y = pack2(o2, o3); \
                    *(uint2*)(op + d0) = u; \
                } \
        }

__device__ void phase_attn(const Params& p, int i, char* smem, int slot) {
    const int tid = tid_l(), lane = tid & 63, w = tid >> 6, r = lane & 31, hh = lane >> 5;
    bf16_t* Ks = (bf16_t*)smem;
    bf16_t* Vs = Ks + 2 * 64 * KS_LD;
    bf16_t* Vf = Ks + 256 * KS_LD;
    int q_ = 0; const int myx = xcc_id_hw() & 7; int* ctr = p.ctr + slot * CTR_SLOT_WORDS;
    volatile int* s_item = (volatile int*)(smem + SMEM_BYTES);
    for (;;) {
        const int tk = tq_next(ctr, 64, myx, q_, s_item, tid);
        if (tk < 0) break;
        const int xq = tk >> 16, idx = tk & 0xffff;
        if (idx >= 32) {
            const int j = idx - 32;
            const int b = xq * 4 + (j >> 3), mixer = (j >> 2) & 1, kvh = (j >> 1) & 1, pair = j & 1;
            const int kcol = (mixer ? 1792 : 512) + kvh * 64;
            const bf16_t* Kg = p.R + (size_t)(b * 256) * 2560 + kcol;
            const bf16_t* Vg = p.vT_ctx + (size_t)(((b * 2 + mixer) * 2 + kvh) * 64) * 256;
            {
                u32x4 kk[8], vv[8];
#pragma unroll
                for (int c = 0; c < 8; c++) {
                    const int ci = tid + 256 * c;
                    kk[c] = *(const u32x4*)(Kg + (size_t)(ci >> 3) * 2560 + (ci & 7) * 8);
                    vv[c] = *(const u32x4*)(Vg + (size_t)(ci >> 5) * 256 + (ci & 31) * 8);
                }
#pragma unroll
                for (int c = 0; c < 8; c++) {
                    const int ci = tid + 256 * c;
                    *(u32x4*)(Ks + (ci >> 3) * KS_LD + (ci & 7) * 8) = kk[c];
                    u32x2* vd = (u32x2*)(Vf + (ci >> 5) * VF_LD + (ci & 31) * 8);
                    vd[0] = vv[c].xy; vd[1] = vv[c].zw;
                }
            }
            __syncthreads();
#pragma unroll 1
            for (int sub = 0; sub < 4; sub++) {
                const int head = kvh * 4 + pair * 2 + (sub >> 1), qb = sub & 1;
                const int tq = b * 256 + qb * 128 + w * 32 + r;
                bf16x8 qf[4];
                {
                    const bf16_t* qp = p.R + (size_t)tq * 2560 + (mixer ? 1280 : 0) + head * 64 + hh * 8;
#pragma unroll
                    for (int ks = 0; ks < 4; ks++) qf[ks] = *(const bf16x8*)(qp + ks * 16);
                }
                float m_run, l_run;
                if (mixer) { m_run = p.sink[i * 8 + head] * 1.4426950408889634f; l_run = hh ? 0.f : 1.f; } else { m_run = -1e30f; l_run = 0.f; }
                f32x16 O[2];
#pragma unroll
                for (int e = 0; e < 16; e++) { O[0][e] = 0.f; O[1][e] = 0.f; }
#pragma unroll 1
                for (int jt = 0; jt < 4; jt++) {
                    const bf16_t* kb = Ks + (jt * 64 + r) * KS_LD + hh * 8;
                    const bf16_t* vb = Vf + r * VF_LD + jt * 64 + 4 * hh;
                    ATT_TILE(kb, KS_LD, vb, VF_LD, false, 0);
                }
                ATT_STORE(tq, (mixer ? 2048 : 768) + head * 64, mixer * 512 + head * 64);
            }
            __syncthreads();
            continue;
        }
        const int mixer = idx >> 4, b = xq >> 2, head = ((xq >> 1) & 1) * 4 + (xq & 1) * 2 + ((idx >> 3) & 1), qb = idx & 7;
        const int kvh = head >> 2;
        const int tq0 = NCTX + b * 1024 + qb * 128;
        const int qcol = (mixer ? 1280 : 0) + head * 64, kcol = (mixer ? 1792 : 512) + kvh * 64, gcol = (mixer ? 2048 : 768) + head * 64;
        int klo = 0, khi = 1024;
        if (mixer) { klo = (qb - 1) * 128; if (klo < 0) klo = 0; khi = (qb + 2) * 128; if (khi > 1024) khi = 1024; }
        const bf16_t* K0 = p.R + (size_t)(NCTX + b * 1024 + klo) * 2560 + kcol; const int ks0 = 2560;
        const bf16_t* V0 = p.vT_lat + (size_t)(((b * 2 + mixer) * 2 + kvh) * 64) * 1024 + klo; const int vs0 = 1024;
        const int nt0 = (khi - klo) >> 6, kpos0 = klo;
        const int ci = ((b * 2 + i) * 2 + mixer) * 2 + kvh;
        const bf16_t* K1 = p.cK + (size_t)ci * 256 * 64; const bf16_t* V1 = p.cVT + (size_t)ci * 64 * 256;
        const bool masked = mixer != 0;
        const int ntiles = nt0 + 4;
        bf16x8 qf[4];
        {
            const bf16_t* qp = p.R + (size_t)(tq0 + w * 32 + r) * 2560 + qcol + hh * 8;
#pragma unroll
            for (int ks = 0; ks < 4; ks++) qf[ks] = *(const bf16x8*)(qp + ks * 16);
        }
        float m_run, l_run;
        if (mixer) { m_run = p.sink[i * 8 + head] * 1.4426950408889634f; l_run = hh ? 0.f : 1.f; } else { m_run = -1e30f; l_run = 0.f; }
        f32x16 O[2];
#pragma unroll
        for (int e = 0; e < 16; e++) { O[0][e] = 0.f; O[1][e] = 0.f; }
        const int qpos = qb * 128 + w * 32 + r;

        u32x4 gk0, gk1, gv0, gv1;
        const int lrow = tid >> 3, lkc = tid & 7;
#define ATT_GLOAD(J) { \
            const bf16_t *Kp_, *Vp_; int kst_, vst_; \
            if ((J) < nt0) { Kp_ = K0 + (size_t)((J) * 64) * ks0; kst_ = ks0; Vp_ = V0 + (J) * 64; vst_ = vs0; } \
            else { Kp_ = K1 + (size_t)(((J) - nt0) * 64) * 64; kst_ = 64; Vp_ = V1 + ((J) - nt0) * 64; vst_ = 256; } \
            gk0 = *(const u32x4*)(Kp_ + (size_t)lrow * kst_ + lkc * 8); \
            gk1 = *(const u32x4*)(Kp_ + (size_t)(lrow + 32) * kst_ + lkc * 8); \
            gv0 = *(const u32x4*)(Vp_ + (size_t)lrow * vst_ + lkc * 8); \
            gv1 = *(const u32x4*)(Vp_ + (size_t)(lrow + 32) * vst_ + lkc * 8); }
#define ATT_SWRITE(BUF) { \
            *(u32x4*)(Ks + ((BUF) * 64 + lrow) * KS_LD + lkc * 8) = gk0; \
            *(u32x4*)(Ks + ((BUF) * 64 + lrow + 32) * KS_LD + lkc * 8) = gk1; \
            u32x2* vd0_ = (u32x2*)(Vs + ((BUF) * 64 + lrow) * VS_LD + lkc * 8); \
            vd0_[0] = gv0.xy; vd0_[1] = gv0.zw; \
            u32x2* vd1_ = (u32x2*)(Vs + ((BUF) * 64 + lrow + 32) * VS_LD + lkc * 8); \
            vd1_[0] = gv1.xy; vd1_[1] = gv1.zw; }
        ATT_GLOAD(0);
        ATT_SWRITE(0);
        __syncthreads();
        for (int j = 0; j + 1 < ntiles; j++) {
            const int buf = j & 1;
            ATT_GLOAD(j + 1);
            __builtin_amdgcn_sched_barrier(0);
            {
                const bf16_t* kb = Ks + (buf * 64 + r) * KS_LD + hh * 8;
                const bf16_t* vb = Vs + (buf * 64 + r) * VS_LD + 4 * hh;
                const bool dmk = masked && j < nt0;
                const int kbase = kpos0 + j * 64 + 4 * hh - qpos;
                ATT_TILE(kb, KS_LD, vb, VS_LD, dmk, kbase);
            }
            __builtin_amdgcn_sched_barrier(0);
            ATT_SWRITE(buf ^ 1);
            __syncthreads();
        }
        {
            const int buf = (ntiles - 1) & 1;
            const bf16_t* kb = Ks + (buf * 64 + r) * KS_LD + hh * 8;
            const bf16_t* vb = Vs + (buf * 64 + r) * VS_LD + 4 * hh;
            ATT_TILE(kb, KS_LD, vb, VS_LD, false, 0);
        }
        __syncthreads();
        ATT_STORE(tq0 + w * 32 + r, gcol, mixer * 512 + head * 64);
    }
}

#define N_PHASES 15
#ifndef REP_MASK
#define REP_MASK 0
#endif
__device__ __forceinline__ void run_phase(const Params& p, int ph, char* smem, int rep) {
    const int slot = ph * 2 + rep;
    if (ph == 0) { phase_p0a(p, smem); return; }
    if (ph == 1) { phase_p0b(p, smem, slot); return; }
    if (ph == 14) { phase_norm(p, 4); return; }
    const int l = (ph - 2) / 3, s = (ph - 2) % 3;
    if (s == 0) { if (l & 1) phase_g1_odd(p, l >> 1, smem, slot); else phase_g1_even(p, l >> 1, smem, slot); }
    else if (s == 1) { if (l & 1) phase_f2(p, l >> 1, smem, slot); else phase_attn(p, l >> 1, smem, slot); }
    else phase_g2(p, l, smem, slot);
}
__device__ __forceinline__ bool probe_repeat(int ph) {
    if (REP_MASK == 0) return false;
    if (ph == 0) return (REP_MASK & 1) != 0;
    if (ph == 1) return (REP_MASK & 2) != 0;
    if (ph == 14) return false;
    const int l = (ph - 2) / 3, s = (ph - 2) % 3;
    if (s == 0) return (l & 1) ? (REP_MASK & 8) != 0 : ((REP_MASK & 4) != 0 && l > 0);
    if (s == 1) return (l & 1) ? (REP_MASK & 32) != 0 : (REP_MASK & 16) != 0;
    return false;
}

__global__ void __launch_bounds__(256, 2) mega_kernel(Params p, int ph_lo, int ph_hi) {
    __shared__ __attribute__((aligned(16))) char smem[SMEM_BYTES + 32];
#if MEGA
    volatile LAS unsigned* st = (volatile LAS unsigned*)(smem + SMEM_BYTES + 16);
    if (threadIdx.x == 0) { st[0] = 0u; st[1] = 0u; }
    __syncthreads();
    XcdBarrier xb = xcd_barrier_post(p.bar, st);
#endif
    for (int ph = ph_lo; ph < ph_hi; ph++) {
        run_phase(p, ph, smem, 0);
#if MEGA
        if (REP_MASK != 0 && probe_repeat(ph)) { xcd_barrier(xb); run_phase(p, ph, smem, 1); }
        if (ph + 1 < ph_hi) xcd_barrier(xb);
#endif
    }
}

extern "C" void kernel_launch(void* const* d_in, const int* in_sizes, int n_in, void* d_out, int out_size, void* d_ws, size_t ws_size,
                              hipStream_t stream) {
    Params p{};
    p.x_prompt = (const float*)d_in[0]; p.x_sample = (const float*)d_in[1];
    p.cache_k_a = (const float*)d_in[2]; p.cache_v_a = (const float*)d_in[3];
    p.cache_k_b = (const float*)d_in[4]; p.cache_v_b = (const float*)d_in[5];
    p.c = (const float*)d_in[6]; p.c_ctx = (const float*)d_in[7]; p.norm_g = (const float*)d_in[8];
    p.ada_w = (const float*)d_in[9]; p.ada_b = (const float*)d_in[10];
    p.even_w_in = (const float*)d_in[11]; p.even_w_out = (const float*)d_in[12];
    p.qk_g_q = (const float*)d_in[13]; p.qk_g_k = (const float*)d_in[14]; p.sink = (const float*)d_in[15];
    p.odd_w_in = (const float*)d_in[16]; p.odd_w_out = (const float*)d_in[17]; p.final_g = (const float*)d_in[18];
    p.out = (float*)d_out;
    char* ws = (char*)d_ws;
    size_t off = 0;
    auto take = [&](size_t bytes) { char* q = ws + off; off += (bytes + 255) & ~(size_t)255; return q; };
    p.bar = (unsigned*)take(XCD_BAR_WORDS * 4);
    p.ctr = (int*)take(36 * CTR_SLOT_WORDS * 4);
    const size_t zero_bytes = off;
    p.mod = (float*)take(4 * 3 * 3072 * 4);
    p.part = (float*)take((size_t)8 * NTOK * 4);
    p.shiftW = (float*)take(4 * 3 * 3072 * 4);
    p.rope = (float2*)take(1024 * 32 * 8);
    p.h = (bf16_t*)take((size_t)NTOK * LDK * 2);
    p.R = (bf16_t*)take((size_t)2048 * LDU * 2 + (size_t)NTOK * 1024 * 2);
    p.mix = (bf16_t*)take((size_t)NTOK * LDK * 2);
    p.winT_e = (bf16_t*)take((size_t)2 * 2560 * LDK * 2);
    p.woutT_e = (bf16_t*)take((size_t)2 * 1024 * LDK * 2);
    p.woutT_o = (bf16_t*)take((size_t)2 * 1024 * LDK * 2);
    p.wfT = (bf16_t*)take((size_t)2 * WF_ROWS * LDK * 2);
    p.wu = (bf16_t*)take((size_t)2 * 1024 * LDK * 2);
    p.D1024 = (bf16_t*)take((size_t)1024 * LDD1 * 2);
    p.D256 = (bf16_t*)take((size_t)256 * LDD2 * 2);
    p.Cc = (bf16_t*)take(256 * LDC * 2);
    p.Sc = (bf16_t*)take(256 * LDC * 2);
    p.vT_ctx = (bf16_t*)take((size_t)32 * 2 * 2 * 64 * 256 * 2);
    p.vT_lat = (bf16_t*)take((size_t)2 * 2 * 2 * 64 * 1024 * 2);
    p.cK = (bf16_t*)take((size_t)16 * 256 * 64 * 2);
    p.cVT = (bf16_t*)take((size_t)16 * 256 * 64 * 2);

    hipMemsetAsync(ws, 0, zero_bytes, stream);

    static int grid_blocks = 0;
    if (!grid_blocks) {
        int dev = 0, cus = 0, per_cu = 0;
        hipGetDevice(&dev);
        hipDeviceGetAttribute(&cus, hipDeviceAttributeMultiprocessorCount, dev);
        hipOccupancyMaxActiveBlocksPerMultiprocessor(&per_cu, mega_kernel, 256, 0);
        if (per_cu > 2) per_cu = 2;
        if (per_cu < 1) per_cu = 1;
        grid_blocks = cus * per_cu;
    }
#if MEGA
    int lo = 0, hi = N_PHASES;
    void* args[] = {&p, &lo, &hi};
    hipError_t e = hipLaunchCooperativeKernel((void*)mega_kernel, dim3(grid_blocks), dim3(256), args, 0, stream);
    if (e != hipSuccess) fprintf(stderr, "cooperative launch failed: %s (grid %d)\n", hipGetErrorString(e), grid_blocks);
#else
    for (int ph = 0; ph < N_PHASES; ph++) mega_kernel<<<grid_blocks, 256, 0, stream>>>(p, ph, ph + 1);
#endif
}
```
